# Optimizing an MI355X kernel written in HIP

```python
import math
import jax, jax.numpy as jnp
from jax import lax
import numpy as np

D_MODEL = 1024
BATCH = 4
SEQ = 4096
DEPTH = 2
DEC_BATCH = 128
DEC_SEQ = 8
PAST_LEN = 8192
PAGE_SIZE = 128

N_HEADS = 16
N_KV_HEADS = 2
HEAD_DIM = 64
GROUP = N_HEADS // N_KV_HEADS
ATTN_WIDTH = N_HEADS * HEAD_DIM
KV_WIDTH = N_KV_HEADS * HEAD_DIM
CONV_DIM = D_MODEL
CONV_GROUPS = 16
CONV_WIDTH = 3
WINDOW = 128
BLOCK = 128
N_BUCKETS = 32
MAX_DISTANCE = 128
D_FF = 4 * D_MODEL
N_BRANCH = 2
N_MOD = 6
RMS_EPS = 1e-6
NEG_INF = -1e30
PROJ_COLS = 3 * CONV_DIM + ATTN_WIDTH + 2 * KV_WIDTH + N_BRANCH * D_MODEL
SPLITS = (CONV_DIM, 2 * CONV_DIM, 3 * CONV_DIM, 3 * CONV_DIM + ATTN_WIDTH,
          3 * CONV_DIM + ATTN_WIDTH + KV_WIDTH, 3 * CONV_DIM + ATTN_WIDTH + 2 * KV_WIDTH)

kernel_name = "hybrid_conv_swa_sink_decoder_step"


def rms_norm(x, g):
    xf = x.astype(jnp.float32)
    y = xf * lax.rsqrt(jnp.mean(xf * xf, axis=-1, keepdims=True) + RMS_EPS)
    return (y * g.astype(jnp.float32)).astype(x.dtype)


def rel_bucket(dist):
    n = jnp.maximum(dist, 0)
    max_exact = N_BUCKETS // 2
    nf = jnp.maximum(n, 1).astype(jnp.float32)
    large = max_exact + (jnp.log(nf / max_exact) / math.log(MAX_DISTANCE / max_exact)
                         * (N_BUCKETS - max_exact)).astype(jnp.int32)
    large = jnp.minimum(large, N_BUCKETS - 1)
    return jnp.where(n < max_exact, n, large)


def window_attention(q, k, v, dist, key_ok, rel_table, sinks):
    n, lq = q.shape[:2]
    lk = k.shape[1]
    qg = q.reshape(n, lq, N_KV_HEADS, GROUP, HEAD_DIM)
    s = jnp.einsum('nqkgd,nskd->nkgqs', qg, k, preferred_element_type=jnp.float32) * (HEAD_DIM ** -0.5)
    bias = rel_table[rel_bucket(dist)].astype(jnp.float32)
    bias = jnp.transpose(bias, (2, 0, 1)).reshape(N_KV_HEADS, GROUP, lq, lk)
    valid = (dist >= 0) & (dist < WINDOW)
    mask = valid[None] & key_ok[:, None, :]
    s = jnp.where(mask[:, None, None], s + bias, NEG_INF)
    sink = jnp.broadcast_to(sinks.astype(jnp.float32).reshape(1, N_KV_HEADS, GROUP, 1, 1),
                            s.shape[:-1] + (1,))
    p = jax.nn.softmax(jnp.concatenate([s, sink], axis=-1), axis=-1)[..., :-1]
    o = jnp.einsum('nkgqs,nskd->nqkgd', p.astype(v.dtype), v)
    return o.reshape(n, lq, ATTN_WIDTH)


def prompt_attention(q, k, v, rel_table, sinks):
    b, s = q.shape[:2]
    nb = s // BLOCK
    qb = q.reshape(b * nb, BLOCK, N_HEADS, HEAD_DIM)

    def band(t):
        tb = t.reshape(b, nb, BLOCK, N_KV_HEADS, HEAD_DIM)
        prev = jnp.pad(tb, ((0, 0), (1, 0), (0, 0), (0, 0), (0, 0)))[:, :-1]
        return jnp.concatenate([prev, tb], axis=2).reshape(b * nb, 2 * BLOCK, N_KV_HEADS, HEAD_DIM)

    dist = (jnp.arange(BLOCK)[:, None] + BLOCK) - jnp.arange(2 * BLOCK)[None, :]
    key_ok = (jnp.arange(nb)[:, None] > 0) | (jnp.arange(2 * BLOCK)[None, :] >= BLOCK)
    key_ok = jnp.tile(key_ok, (b, 1))
    o = window_attention(qb, band(k), band(v), dist, key_ok, rel_table, sinks)
    w = min(WINDOW, s)
    return o.reshape(b, s, ATTN_WIDTH), k[:, -w:], v[:, -w:]


def sample_attention(q, k, v, k_buf, v_buf, rel_table, sinks):
    buf = k_buf.shape[1]
    t = q.shape[1]
    kk = jnp.concatenate([k_buf, k.astype(k_buf.dtype)], axis=1)
    vv = jnp.concatenate([v_buf, v.astype(v_buf.dtype)], axis=1)
    q_pos = buf + jnp.arange(t)
    k_pos = jnp.arange(buf + t)
    dist = q_pos[:, None] - k_pos[None, :]
    key_ok = jnp.ones((1, buf + t), dtype=bool)
    o = window_attention(q, kk, vv, dist, key_ok, rel_table, sinks)
    return o, kk[:, -buf:], vv[:, -buf:]


def short_conv(u, prefix, conv_w):
    ext = jnp.concatenate([prefix.astype(u.dtype), u], axis=1)
    L = u.shape[1]
    y = conv_w[0] * ext[:, 0:L]
    for j in range(1, CONV_WIDTH):
        y = y + conv_w[j] * ext[:, j:j + L]
    return y, ext[:, -(CONV_WIDTH - 1):]


def trunk_layer(x, c, conv_prefix, attn_fn, w_ada, b_ada, g_pre1, w_in, conv_w, w_br_conv,
                w_br_attn, w_o, sinks, g_post1, g_pre2, w_ff1, w_ff2, g_post2, rel_table):
    n, L = x.shape[:2]
    mod = jnp.einsum('bd,de->be', jax.nn.silu(c), w_ada) + b_ada
    sh1, sc1, ga1, sh2, sc2, ga2 = [m[:, None, :] for m in jnp.split(mod, N_MOD, axis=-1)]
    h = rms_norm(x, g_pre1) * (1 + sc1) + sh1
    proj = jnp.einsum('bld,de->ble', h, w_in)
    b_g, c_g, xc, q, k, v, gates = jnp.split(proj, SPLITS, axis=-1)
    conv_out, conv_tail = short_conv(c_g * xc, conv_prefix, conv_w)
    y_conv = jnp.einsum('blc,cd->bld', b_g * conv_out, w_br_conv)
    attn_out, k_tail, v_tail = attn_fn(q.reshape(n, L, N_HEADS, HEAD_DIM),
                                       k.reshape(n, L, N_KV_HEADS, HEAD_DIM),
                                       v.reshape(n, L, N_KV_HEADS, HEAD_DIM), rel_table, sinks)
    y_attn = jnp.einsum('bla,ad->bld', attn_out, w_br_attn)
    g_conv, g_attn = jnp.split(jax.nn.sigmoid(gates), N_BRANCH, axis=-1)
    mixed = jnp.einsum('bld,de->ble', g_conv * y_conv + g_attn * y_attn, w_o)
    x = x + ga1 * rms_norm(mixed, g_post1)
    h2 = rms_norm(x, g_pre2) * (1 + sc2) + sh2
    ff = jnp.einsum('blf,fd->bld', jnp.square(jax.nn.relu(jnp.einsum('bld,df->blf', h2, w_ff1))), w_ff2)
    x = x + ga2 * rms_norm(ff, g_post2)
    return x, conv_tail, k_tail, v_tail


def setup_inputs(seed: int = 0) -> dict:
    key = jax.random.key(seed)
    ks = jax.random.split(key, 26)

    def nrm(k, shape, scale):
        return jax.random.normal(k, shape, jnp.float32) * scale

    buf = min(WINDOW, PAST_LEN)
    return {
        "x_prompt": nrm(ks[0], (BATCH, SEQ, D_MODEL), 1.0),
        "x_sample": nrm(ks[1], (DEC_BATCH, DEC_SEQ, D_MODEL), 1.0),
        "c_prompt": nrm(ks[2], (BATCH, D_MODEL), 1.0),
        "c_sample": nrm(ks[3], (DEC_BATCH, D_MODEL), 1.0),
        "state_conv": nrm(ks[4], (DEPTH, DEC_BATCH, CONV_WIDTH - 1, CONV_DIM), 1.0),
        "cache_k": nrm(ks[5], (DEPTH, DEC_BATCH, buf, N_KV_HEADS, HEAD_DIM), 1.0),
        "cache_v": nrm(ks[6], (DEPTH, DEC_BATCH, buf, N_KV_HEADS, HEAD_DIM), 1.0),
        "w_ada": nrm(ks[7], (DEPTH, D_MODEL, N_MOD * D_MODEL), 0.3 * D_MODEL ** -0.5),
        "b_ada": nrm(ks[8], (DEPTH, N_MOD * D_MODEL), 0.02),
        "g_pre1": 1.0 + nrm(ks[9], (DEPTH, D_MODEL), 0.05),
        "w_in": nrm(ks[10], (DEPTH, D_MODEL, PROJ_COLS), D_MODEL ** -0.5),
        "conv_w": nrm(ks[11], (DEPTH, CONV_WIDTH, CONV_DIM), CONV_WIDTH ** -0.5),
        "w_br_conv": nrm(ks[12], (DEPTH, CONV_DIM, D_MODEL), CONV_DIM ** -0.5),
        "w_br_attn": nrm(ks[13], (DEPTH, ATTN_WIDTH, D_MODEL), ATTN_WIDTH ** -0.5),
        "w_o": nrm(ks[14], (DEPTH, D_MODEL, D_MODEL), D_MODEL ** -0.5),
        "sinks": nrm(ks[15], (DEPTH, N_HEADS), 0.5),
        "g_post1": 1.0 + nrm(ks[16], (DEPTH, D_MODEL), 0.05),
        "g_pre2": 1.0 + nrm(ks[17], (DEPTH, D_MODEL), 0.05),
        "w_ff1": nrm(ks[18], (DEPTH, D_MODEL, D_FF), D_MODEL ** -0.5),
        "w_ff2": nrm(ks[19], (DEPTH, D_FF, D_MODEL), D_FF ** -0.5),
        "g_post2": 1.0 + nrm(ks[20], (DEPTH, D_MODEL), 0.05),
        "rel_table": nrm(ks[21], (N_BUCKETS, N_HEADS), 0.5),
    }


def reference(x_prompt, x_sample, c_prompt, c_sample, state_conv, cache_k, cache_v,
              w_ada, b_ada, g_pre1, w_in, conv_w, w_br_conv, w_br_attn, w_o, sinks,
              g_post1, g_pre2, w_ff1, w_ff2, g_post2, rel_table):
    xp, xs = x_prompt, x_sample
    conv_p, k_p, v_p, conv_s, k_s, v_s = [], [], [], [], [], []
    zero_prefix = jnp.zeros((xp.shape[0], CONV_WIDTH - 1, CONV_DIM), xp.dtype)
    for l in range(DEPTH):
        weights = (w_ada[l], b_ada[l], g_pre1[l], w_in[l], conv_w[l], w_br_conv[l], w_br_attn[l],
                   w_o[l], sinks[l], g_post1[l], g_pre2[l], w_ff1[l], w_ff2[l], g_post2[l], rel_table)
        xp, ct, kt, vt = trunk_layer(xp, c_prompt, zero_prefix, prompt_attention, *weights)
        conv_p.append(ct); k_p.append(kt); v_p.append(vt)

        def samp_attn(q, k, v, tbl, snk, kb=cache_k[l], vb=cache_v[l]):
            return sample_attention(q, k, v, kb, vb, tbl, snk)

        xs, ct, kt, vt = trunk_layer(xs, c_sample, state_conv[l], samp_attn, *weights)
        conv_s.append(ct); k_s.append(kt); v_s.append(vt)
    conv_prompt = jnp.stack(conv_p)
    k_prompt = jnp.stack(k_p)
    v_prompt = jnp.stack(v_p)
    conv_sample = jnp.stack(conv_s)
    k_sample = jnp.stack(k_s)
    v_sample = jnp.stack(v_s)
    return (xp, xs, conv_prompt, k_prompt, v_prompt, conv_sample, k_sample, v_sample)
```

```cpp
#include <hip/hip_runtime.h>
#include <cstdio>
#include <cstdint>

#define LAS __attribute__((address_space(3)))
#define GAS __attribute__((address_space(1)))
typedef unsigned short bf16_t;
typedef short bf16x8 __attribute__((ext_vector_type(8)));
typedef short s16x4 __attribute__((ext_vector_type(4)));
typedef float f32x2 __attribute__((ext_vector_type(2)));
typedef float f32x4 __attribute__((ext_vector_type(4)));
typedef float f32x16 __attribute__((ext_vector_type(16)));
typedef unsigned u32x2 __attribute__((ext_vector_type(2)));
typedef unsigned u32x4 __attribute__((ext_vector_type(4)));
typedef __bf16 bf16x2_t __attribute__((ext_vector_type(2)));

#ifndef PHMASK
#define PHMASK 1023
#endif
#ifndef MK_PER_PHASE_LAUNCH
#define MK_PER_PHASE_LAUNCH 0
#endif

constexpr int D = 1024, SEQ = 4096, NB = 4, NS = 128, TS = 8, NH = 16, HD = 64, FF = 4096, NMOD = 6;
constexpr int MP = NB * SEQ, MS = NS * TS, M = MP + MS;
constexpr int NMROW = NB + NS;
constexpr int PIN = 6400;
constexpr int LD = 5376;
constexpr int PC_BG = 0, PC_U = 1024, PC_Q = 2048, PC_K = 3072, PC_V = 3200, PC_G = 3328;
constexpr float RMS_EPS = 1e-6f, LOG2E = 1.4426950408889634f, QSCALE = 0.125f * 1.4426950408889634f, NEG = -1e30f;

enum { I_XP = 0, I_XS, I_CP, I_CS, I_SCONV, I_CK, I_CV, I_WADA, I_BADA, I_GPRE1, I_WIN, I_CONVW, I_WBC, I_WBA, I_WO, I_SINKS, I_GPOST1, I_GPRE2, I_WFF1, I_WFF2, I_GPOST2, I_REL };
constexpr size_t O_YP = 0, O_YS = (size_t)MP * D, O_CONVP = O_YS + (size_t)MS * D, O_KP = O_CONVP + 2 * NB * 2 * D, O_VP = O_KP + 2 * NB * 128 * 128,
                 O_CONVS = O_VP + 2 * NB * 128 * 128, O_KS = O_CONVS + 2 * NS * 2 * D, O_VS = O_KS + (size_t)2 * NS * 128 * 128, O_END = O_VS + (size_t)2 * NS * 128 * 128;

constexpr size_t KiB = 1024, MiB = 1u << 20;
constexpr size_t WS_CTL = 0, CTL_ZERO_BYTES = 256 * KiB;
constexpr size_t WS_W = 512 * KiB;
constexpr size_t WE_IN = 0, WE_CA = (size_t)PIN * D, WE_O = WE_CA + 2048 * (size_t)D, WE_1 = WE_O + (size_t)D * D, WE_2 = WE_1 + (size_t)FF * D, WE_END = WE_2 + (size_t)D * FF;
constexpr size_t WS_MOD = WS_W + 35 * MiB;
constexpr size_t WS_BIAS = WS_MOD + (size_t)2 * NMROW * NMOD * D * 4;
constexpr size_t WS_H = WS_W + 35 * MiB + 6 * MiB + 256 * KiB;
constexpr size_t WS_PROJ = WS_H + (size_t)M * D * 2;
constexpr size_t WS_END = WS_PROJ + (size_t)M * LD * 2;
static_assert(WE_END * 2 <= 35 * MiB && WS_BIAS + 16 * 128 * 4 <= WS_H && WS_END <= 256 * MiB, "d_ws map");
constexpr size_t PROJ_FFO = (size_t)M * FF * 2;
static_assert(PROJ_FFO + (size_t)M * D * 2 <= (size_t)M * LD * 2, "FFO overlay");

namespace pg8 {
constexpr int BM = 256, BK = 64, HALF = 128, HTB = HALF * BK * 2, STAGE_BYTES = 8 * HTB, NXCD = 8, WGM = 8;
__host__ __device__ __forceinline__ int lds_byte(int r, int c) { const int st = (r >> 4) * 2 + (c >> 5), rr = r & 15, cc = c & 31, ob = rr * 64 + cc * 2; return st * 1024 + (ob ^ (((ob >> 9) & 1) << 5)); }
__host__ __device__ __forceinline__ void stage_rc(int b, int& R, int& C) { const int st = b / 1024, sb = b % 1024, swz = sb ^ (((sb >> 9) & 1) << 5); R = (st >> 1) * 16 + swz / 64; C = (st & 1) * 32 + (swz % 64) / 2; }
__host__ __device__ __forceinline__ int perm32(int rho) { const int n = rho >> 4, i = rho & 15; return 8 * (i >> 2) + 4 * n + (i & 3); }

struct Unit { int pm, pn, br; };
struct Gemm { const bf16_t* A; const bf16_t* Bt; int lda, K; size_t a_br, b_br; };

struct StaticOrder {
    int nM, nN, nwg, G, c, pairs;
    __device__ void init(int M_, int N_, int G_, int c_, int pairs_) { nM = M_ / BM; nN = N_ / BM; nwg = nM * nN; G = G_; c = c_; pairs = pairs_; }
    __device__ __forceinline__ bool next(int i, Unit& u) const {
        const int ii = pairs ? (i >> 1) : i; u.br = pairs ? (i & 1) : 0;
        const long L = (long)ii * G + c; if (L >= nwg) return false;
        int wgid = (int)L; { const int q = nwg / NXCD, r = nwg % NXCD, xcd = wgid % NXCD, off = wgid / NXCD; wgid = (xcd < r ? xcd * (q + 1) : r * (q + 1) + (xcd - r) * q) + off; }
        const int nig = WGM * nN, gid = wgid / nig, fm = gid * WGM, gsz = (nM - fm) < WGM ? (nM - fm) : WGM;
        u.pm = fm + ((wgid % nig) % gsz); u.pn = (wgid % nig) / gsz; return true;
    }
};

__device__ __forceinline__ unsigned cvt_pk_bf16(float lo, float hi) { f32x2 v = {lo, hi}; bf16x2_t b = __builtin_convertvector(v, bf16x2_t); return __builtin_bit_cast(unsigned, b); }
__device__ __forceinline__ float bf_lo(unsigned w) { return __builtin_bit_cast(float, w << 16); }
__device__ __forceinline__ float bf_hi(unsigned w) { return __builtin_bit_cast(float, w & 0xffff0000u); }
__device__ __forceinline__ float sigmoidf_(float x) { return __builtin_amdgcn_rcpf(1.0f + __builtin_amdgcn_exp2f(-x * LOG2E)); }

enum { EPI_PROJ = 0, EPI_BRANCH = 1, EPI_F32 = 2, EPI_RELU2 = 3, EPI_BF16 = 4 };
template <int KIND> struct Epi {
    bf16_t* proj; void* out; int ldo;
    __device__ __forceinline__ void operator()(const f32x4 (&acc)[2][2][4][2], const Unit& u, int wr, int wc, int fr, int fq) const {
        const int row0 = u.pm * BM + wr * 64 + fr, cw = wc * 32 + 8 * fq;
        if constexpr (KIND == EPI_PROJ) {
            const int pn = u.pn;
            if (pn >= 4 && pn < 12) {
                const int col = PC_U + 128 * (pn - 4) + cw;
#pragma unroll
                for (int ai = 0; ai < 2; ++ai)
#pragma unroll
                    for (int m = 0; m < 4; ++m) { bf16_t* rp = proj + (size_t)(row0 + ai * HALF + m * 16) * LD + col;
                        const f32x4 v0 = acc[ai][0][m][0] * acc[ai][1][m][0], v1 = acc[ai][0][m][1] * acc[ai][1][m][1];
                        u32x4 w; w.x = cvt_pk_bf16(v0[0], v0[1]); w.y = cvt_pk_bf16(v0[2], v0[3]); w.z = cvt_pk_bf16(v1[0], v1[1]); w.w = cvt_pk_bf16(v1[2], v1[3]);
                        *(u32x4*)rp = w; }
            } else {
                const int colt = pn < 4 ? 256 * pn : 256 * pn - 1024; const float sc = (pn >= 12 && pn < 16) ? QSCALE : 1.0f;
                const int col = colt + cw;
#pragma unroll
                for (int ai = 0; ai < 2; ++ai)
#pragma unroll
                    for (int m = 0; m < 4; ++m) { bf16_t* rp = proj + (size_t)(row0 + ai * HALF + m * 16) * LD + col;
#pragma unroll
                        for (int bj = 0; bj < 2; ++bj) { const f32x4 v0 = acc[ai][bj][m][0] * sc, v1 = acc[ai][bj][m][1] * sc;
                            u32x4 w; w.x = cvt_pk_bf16(v0[0], v0[1]); w.y = cvt_pk_bf16(v0[2], v0[3]); w.z = cvt_pk_bf16(v1[0], v1[1]); w.w = cvt_pk_bf16(v1[2], v1[3]);
                            *(u32x4*)(rp + bj * HALF) = w; } }
            }
        } else if constexpr (KIND == EPI_BRANCH) {
            const int br = u.br, col = 256 * u.pn + cw;
            bf16_t* U = (bf16_t*)out;
#pragma unroll
            for (int ai = 0; ai < 2; ++ai)
#pragma unroll
                for (int m = 0; m < 4; ++m) { const size_t row = (size_t)(row0 + ai * HALF + m * 16); bf16_t* rp = proj + row * LD;
#pragma unroll
                    for (int bj = 0; bj < 2; ++bj) {
                        const u32x4 g = *(const u32x4*)(rp + PC_G + br * 1024 + col + bj * HALF);
                        f32x4 v0 = acc[ai][bj][m][0], v1 = acc[ai][bj][m][1];
                        v0[0] *= sigmoidf_(bf_lo(g.x)); v0[1] *= sigmoidf_(bf_hi(g.x)); v0[2] *= sigmoidf_(bf_lo(g.y)); v0[3] *= sigmoidf_(bf_hi(g.y));
                        v1[0] *= sigmoidf_(bf_lo(g.z)); v1[1] *= sigmoidf_(bf_hi(g.z)); v1[2] *= sigmoidf_(bf_lo(g.w)); v1[3] *= sigmoidf_(bf_hi(g.w));
                        if (br) { const u32x4 t = *(const u32x4*)(rp + PC_U + col + bj * HALF);
                            v0[0] += bf_lo(t.x); v0[1] += bf_hi(t.x); v0[2] += bf_lo(t.y); v0[3] += bf_hi(t.y); v1[0] += bf_lo(t.z); v1[1] += bf_hi(t.z); v1[2] += bf_lo(t.w); v1[3] += bf_hi(t.w); }
                        u32x4 w; w.x = cvt_pk_bf16(v0[0], v0[1]); w.y = cvt_pk_bf16(v0[2], v0[3]); w.z = cvt_pk_bf16(v1[0], v1[1]); w.w = cvt_pk_bf16(v1[2], v1[3]);
                        if (br) *(u32x4*)(U + row * D + col + bj * HALF) = w; else *(u32x4*)(rp + PC_U + col + bj * HALF) = w; }
                    asm volatile("" ::: "memory"); }
        } else if constexpr (KIND == EPI_F32) {
            float* O = (float*)out; const int col = 256 * u.pn + cw;
#pragma unroll
            for (int ai = 0; ai < 2; ++ai)
#pragma unroll
                for (int m = 0; m < 4; ++m) { float* rp = O + (size_t)(row0 + ai * HALF + m * 16) * ldo + col;
#pragma unroll
                    for (int bj = 0; bj < 2; ++bj) { *(f32x4*)(rp + bj * HALF) = acc[ai][bj][m][0]; *(f32x4*)(rp + bj * HALF + 4) = acc[ai][bj][m][1]; } }
        } else {
            bf16_t* O = (bf16_t*)out; const int col = 256 * u.pn + cw;
#pragma unroll
            for (int ai = 0; ai < 2; ++ai)
#pragma unroll
                for (int m = 0; m < 4; ++m) { bf16_t* rp = O + (size_t)(row0 + ai * HALF + m * 16) * ldo + col;
#pragma unroll
                    for (int bj = 0; bj < 2; ++bj) { f32x4 v0 = acc[ai][bj][m][0], v1 = acc[ai][bj][m][1];
                        if constexpr (KIND == EPI_RELU2) {
#pragma unroll
                            for (int e = 0; e < 4; ++e) { const float a = fmaxf(v0[e], 0.f), b = fmaxf(v1[e], 0.f); v0[e] = a * a; v1[e] = b * b; } }
                        u32x4 w; w.x = cvt_pk_bf16(v0[0], v0[1]); w.y = cvt_pk_bf16(v0[2], v0[3]); w.z = cvt_pk_bf16(v1[0], v1[1]); w.w = cvt_pk_bf16(v1[2], v1[3]);
                        *(u32x4*)(rp + bj * HALF) = w; } }
        }
    }
};

template <class EpiT>
__device__ __forceinline__ void gemm_phase(LAS unsigned char* lds, const Gemm g, const StaticOrder& S, const EpiT& E, const int tid) {
    const int wid = __builtin_amdgcn_readfirstlane(tid >> 6), lane = tid & 63, wr = wid >> 2, wc = wid & 3, fr = lane & 15, fq = lane >> 4;
    const int K = g.K, lda = g.lda, nt = K / BK;
    unsigned voffA[2], voffB[2];
#pragma unroll
    for (int i = 0; i < 2; ++i) { int R, C; stage_rc(tid * 16 + i * 8192, R, C); const int Rb = (R & ~31) + perm32(R & 31);
        voffA[i] = (unsigned)(R * lda + C) * 2u; voffB[i] = (unsigned)(Rb * K + C) * 2u; }
    const size_t kstep = (size_t)(BK * 2);
    const size_t hstepA = (size_t)HALF * lda * 2, hstepB = (size_t)HALF * K * 2;
    const size_t tstepA = 2 * hstepA, tstepB = 2 * hstepB;
    const unsigned ldsw = (unsigned)wid * 1024u;
    const int aoff = lds_byte(wr * 64 + fr, fq * 8), boff = lds_byte(wc * 32 + fr, fq * 8);
#define PG8_SA(b, h) (((b) * 2 + (h)) * HTB)
#define PG8_SB(b, h) ((4 + (b) * 2 + (h)) * HTB)
#define PG8_STAGE(bufoff, gbase, voff) do { _Pragma("unroll") for (int _i = 0; _i < 2; ++_i) \
        __builtin_amdgcn_global_load_lds((const unsigned*)((const char*)(gbase) + (voff)[_i]), (LAS unsigned*)(lds + (bufoff) + ldsw + _i * 8192), 16, 0, 0); } while (0)
#define PG8_LDA(dst, b, h) do { _Pragma("unroll") for (int m = 0; m < 4; ++m) _Pragma("unroll") for (int k = 0; k < 2; ++k) dst[m][k] = *(const LAS bf16x8*)(lds + PG8_SA(b, h) + aoff + m * 2048 + k * 1024); } while (0)
#define PG8_LDB(dst, b, h) do { _Pragma("unroll") for (int n = 0; n < 2; ++n) _Pragma("unroll") for (int k = 0; k < 2; ++k) dst[n][k] = *(const LAS bf16x8*)(lds + PG8_SB(b, h) + boff + n * 2048 + k * 1024); } while (0)
#define PG8_MMA(ai, bj, At, Bt) do { __builtin_amdgcn_s_setprio(1); _Pragma("unroll") for (int m = 0; m < 4; ++m) _Pragma("unroll") for (int n = 0; n < 2; ++n) _Pragma("unroll") for (int k = 0; k < 2; ++k) \
        acc[ai][bj][m][n] = __builtin_amdgcn_mfma_f32_16x16x32_bf16(Bt[n][k], At[m][k], acc[ai][bj][m][n], 0, 0, 0); __builtin_amdgcn_s_setprio(0); } while (0)
#define PG8_WAIT_V(n) asm volatile("s_waitcnt vmcnt(" #n ")" ::: "memory")
#define PG8_WAIT_L(n) asm volatile("s_waitcnt lgkmcnt(" #n ")" ::: "memory")
#define PG8_BAR __builtin_amdgcn_s_barrier()
#define PG8_SCHED __builtin_amdgcn_sched_barrier(0)
#define PG8_PTRS(u, pa, pb) do { pa = (const char*)g.A + (size_t)(u).pm * tstepA + (size_t)(u).br * g.a_br; pb = (const char*)g.Bt + (size_t)(u).pn * tstepB + (size_t)(u).br * g.b_br; } while (0)
    Unit cur, nxt; int ui = 0;
    if (!S.next(0, cur)) return;
    f32x4 acc[2][2][4][2];
#pragma unroll
    for (int a = 0; a < 2; ++a)
#pragma unroll
        for (int b = 0; b < 2; ++b)
#pragma unroll
            for (int m = 0; m < 4; ++m)
#pragma unroll
                for (int n = 0; n < 2; ++n) acc[a][b][m][n] = (f32x4){0.f, 0.f, 0.f, 0.f};
    bf16x8 At[4][2], B0[2][2], B1[2][2];
    const char* cA; const char* cB; PG8_PTRS(cur, cA, cB);
    PG8_STAGE(PG8_SB(0, 0), cB, voffB); PG8_STAGE(PG8_SB(0, 1), cB + hstepB, voffB); PG8_STAGE(PG8_SA(0, 0), cA, voffA); PG8_STAGE(PG8_SA(0, 1), cA + hstepA, voffA);
    if (wr == 1) PG8_BAR;
    PG8_WAIT_V(2); PG8_BAR;
    PG8_STAGE(PG8_SB(1, 0), cB + kstep, voffB); PG8_STAGE(PG8_SA(1, 0), cA + kstep, voffA); PG8_STAGE(PG8_SB(1, 1), cB + hstepB + kstep, voffB);
    PG8_WAIT_V(6); PG8_BAR;
    for (;;) {
        const bool has_next = S.next(ui + 1, nxt);
        const char* nA = cA; const char* nB = cB; if (has_next) PG8_PTRS(nxt, nA, nB);
        for (int t = 0; t < nt; t += 2) {
            const bool last = (t == nt - 2);
            const char* a1 = cA + (size_t)(t + 1) * kstep;
            const char* a2 = last ? nA : cA + (size_t)(t + 2) * kstep; const char* b2 = last ? nB : cB + (size_t)(t + 2) * kstep;
            const char* a3 = a2 + kstep; const char* b3 = b2 + kstep;
            PG8_LDB(B0, 0, 0); PG8_LDB(B1, 0, 1); PG8_SCHED; PG8_LDA(At, 0, 0); PG8_STAGE(PG8_SA(1, 1), a1 + hstepA, voffA);
            PG8_WAIT_V(8); PG8_WAIT_L(0); PG8_BAR; PG8_MMA(0, 0, At, B0); PG8_MMA(0, 1, At, B1); PG8_BAR; PG8_SCHED;
            PG8_LDA(At, 0, 1); PG8_STAGE(PG8_SB(0, 0), b2, voffB); PG8_STAGE(PG8_SB(0, 1), b2 + hstepB, voffB); PG8_STAGE(PG8_SA(0, 0), a2, voffA);
            PG8_WAIT_V(8); PG8_WAIT_L(0); PG8_BAR; PG8_MMA(1, 0, At, B0); PG8_MMA(1, 1, At, B1); PG8_BAR; PG8_SCHED;
            PG8_LDB(B0, 1, 0); PG8_LDB(B1, 1, 1); PG8_SCHED; PG8_LDA(At, 1, 0); PG8_STAGE(PG8_SA(0, 1), a2 + hstepA, voffA);
            PG8_WAIT_V(8); PG8_WAIT_L(0); PG8_BAR; PG8_MMA(0, 0, At, B0); PG8_MMA(0, 1, At, B1); PG8_BAR; PG8_SCHED;
            PG8_LDA(At, 1, 1); PG8_STAGE(PG8_SB(1, 0), b3, voffB); PG8_STAGE(PG8_SB(1, 1), b3 + hstepB, voffB); PG8_STAGE(PG8_SA(1, 0), a3, voffA);
            PG8_WAIT_V(8); PG8_WAIT_L(0); PG8_BAR; PG8_MMA(1, 0, At, B0); PG8_MMA(1, 1, At, B1); PG8_BAR; PG8_SCHED;
        }
        if (wr == 0) PG8_BAR;
        E(acc, cur, wr, wc, fr, fq);
        if (!has_next) break;
#pragma unroll
        for (int a = 0; a < 2; ++a)
#pragma unroll
            for (int b = 0; b < 2; ++b)
#pragma unroll
                for (int m = 0; m < 4; ++m)
#pragma unroll
                    for (int n = 0; n < 2; ++n) acc[a][b][m][n] = (f32x4){0.f, 0.f, 0.f, 0.f};
        cur = nxt; cA = nA; cB = nB; ++ui;
        if (wr == 1) PG8_BAR;
    }
    PG8_WAIT_V(0);
    PG8_BAR;
#undef PG8_SA
#undef PG8_SB
#undef PG8_STAGE
#undef PG8_LDA
#undef PG8_LDB
#undef PG8_MMA
#undef PG8_WAIT_V
#undef PG8_WAIT_L
#undef PG8_BAR
#undef PG8_SCHED
#undef PG8_PTRS
}
}

constexpr int NWAVES = 8, NTHR = NWAVES * 64;
constexpr int RING_BYTES = 131072, LDSCTL_OFF = RING_BYTES, MISC_OFF = LDSCTL_OFF + 320, LDS_BYTES = 147456;
constexpr int NPHASE = 18;
constexpr int CW_BAR = 4096;

#define RLX_AGENT __ATOMIC_RELAXED, __HIP_MEMORY_SCOPE_AGENT
#define LDS_WAIT() asm volatile("s_waitcnt lgkmcnt(0)" ::: "memory")
__device__ __forceinline__ unsigned f2bf(float f) { unsigned u = __builtin_bit_cast(unsigned, f); return (u + 0x7fffu + ((u >> 16) & 1u)) >> 16; }
__device__ __forceinline__ unsigned pk2(float lo, float hi) { return f2bf(lo) | (f2bf(hi) << 16); }
using pg8::bf_lo; using pg8::bf_hi; using pg8::cvt_pk_bf16;

#define XB_TMO      128
#define XB_XCNT(j)  (256  + 64 * (j))
#define XB_XSUB(j)  (1280 + 64 * (j))
#define XB_XGEN(j)  (2304 + 64 * (j))
#define XB_TOP      3328
#define XB_TOPGEN   3392
#define XCD_BAR_WORDS 3456
#define XB_SPIN_CAP (1u << 18)
__device__ __forceinline__ unsigned xb_ld(unsigned* p)              { return __hip_atomic_load(p, __ATOMIC_RELAXED, __HIP_MEMORY_SCOPE_AGENT); }
__device__ __forceinline__ unsigned xb_add(unsigned* p, unsigned v) { return __hip_atomic_fetch_add(p, v, __ATOMIC_RELAXED, __HIP_MEMORY_SCOPE_AGENT); }
__device__ __forceinline__ unsigned xb_xcc_id() { return (unsigned)__builtin_amdgcn_s_getreg((3 << 11) | 20) & 0xFu; }
#define XB_SPIN(cond, bar) do { unsigned _sp = 0; while (cond) { __builtin_amdgcn_s_sleep(1); \
    if ((++_sp & 255u) == 0u) { if (xb_ld(&(bar)[XB_TMO])) break; if (_sp > XB_SPIN_CAP) { atomicAdd(&(bar)[XB_TMO], 1u); break; } } } } while (0)
struct XcdBarrier { unsigned* bar; unsigned x; volatile LAS unsigned* st; };
__device__ __forceinline__ XcdBarrier xcd_barrier_post(unsigned* bar, volatile LAS unsigned* st) {
    XcdBarrier b; b.bar = bar; b.x = xb_xcc_id(); b.st = st;
    if (threadIdx.x == 0) (void)xb_add(&bar[XB_XCNT(b.x)], 1u);
    return b;
}
__device__ __forceinline__ void xcd_barrier_complete(unsigned* bar, unsigned x, unsigned& nloc, unsigned& nx) {
    const unsigned G = gridDim.x * gridDim.y * gridDim.z;
    unsigned sum, cnt, mine, sp = 0u;
    for (;;) {
        sum = 0u; cnt = 0u; mine = 0u;
#pragma unroll 1
        for (unsigned j = 0; j < 16; ++j) { const unsigned c = xb_ld(&bar[XB_XCNT(j)]); sum += c; cnt += (c > 0u) ? 1u : 0u; mine = (j == x) ? c : mine; }
        if (sum == G) break;
        __builtin_amdgcn_s_sleep(1);
        if ((++sp & 255u) == 0u) { if (xb_ld(&bar[XB_TMO])) break; if (sp > XB_SPIN_CAP) { atomicAdd(&bar[XB_TMO], 1u); break; } }
    }
    nloc = mine > 0u ? mine : 1u; nx = cnt > 0u ? cnt : 1u;
}
__device__ __forceinline__ void xcd_barrier(const XcdBarrier& b) {
    asm volatile("s_waitcnt vmcnt(0)" ::: "memory");
    __syncthreads();
    if (threadIdx.x == 0) {
        unsigned* bar = b.bar;
        __builtin_amdgcn_s_waitcnt(0);
        unsigned nloc = b.st[0], nx = b.st[1];
        if (nloc == 0u) { xcd_barrier_complete(bar, b.x, nloc, nx); b.st[0] = nloc; b.st[1] = nx; }
        const unsigned old = xb_add(&bar[XB_XSUB(b.x)], 1u);
        const unsigned gen = old / nloc;
        if (old + 1u == (gen + 1u) * nloc) {
            __builtin_amdgcn_fence(__ATOMIC_RELEASE, "agent");
            asm volatile("s_waitcnt vmcnt(0)" ::: "memory");
            const unsigned og = xb_add(&bar[XB_TOP], 1u);
            const unsigned tg = og / nx;
            if (og + 1u == (tg + 1u) * nx) xb_add(&bar[XB_TOPGEN], 1u);
            else XB_SPIN(xb_ld(&bar[XB_TOPGEN]) == tg, bar);
            __builtin_amdgcn_fence(__ATOMIC_ACQUIRE, "agent");
            xb_add(&bar[XB_XGEN(b.x)], 1u);
            asm volatile("s_waitcnt vmcnt(0)" ::: "memory");
        } else {
            XB_SPIN(xb_ld(&bar[XB_XGEN(b.x)]) == gen, bar);
            __builtin_amdgcn_fence(__ATOMIC_ACQUIRE, "agent");
            asm volatile("s_waitcnt vmcnt(0)" ::: "memory");
        }
    }
    __syncthreads();
}

struct Args { const float* in[22]; float* out; unsigned char* ws; int ph_lo, ph_hi; };
typedef const __attribute__((address_space(4))) Args* ArgsP;
__device__ __forceinline__ ArgsP args_ptr() { ArgsP p = (ArgsP)__builtin_amdgcn_kernarg_segment_ptr(); asm volatile("" : "+s"(p)); return p; }

__device__ __forceinline__ float wave_sum(float v) {
#pragma unroll
    for (int o = 1; o < 64; o <<= 1) v += __shfl_xor(v, o);
    return v;
}

__device__ __forceinline__ int win_dst_row(int c) {
    if (c >= 1024 && c < 3072) { const int x = c >= 2048, ch = c - 1024 - 1024 * x; return 1024 + 256 * (ch >> 7) + 128 * x + (ch & 127); }
    return c;
}
__device__ __forceinline__ void transpose_item(const float* W, int K, int N, bf16_t* WT, int row_off, bool perm_in, LAS float* scr, int item, int lane) {
    const int nblk = N / 32, kb = item / nblk, nb = item % nblk, k0 = 64 * kb, n0 = 32 * nb;
#pragma unroll 8
    for (int i = 0; i < 32; ++i) { const int kk = 2 * i + (lane >> 5); scr[kk * 33 + (lane & 31)] = W[(size_t)(k0 + kk) * N + n0 + (lane & 31)]; }
    LDS_WAIT(); asm volatile("" ::: "memory");
    const int c = lane & 7;
    const int r0 = row_off + (perm_in ? win_dst_row(n0) : n0);
#pragma unroll
    for (int j = 0; j < 4; ++j) { const int n = (lane >> 3) + 8 * j; const LAS float* s = scr + (8 * c) * 33 + n;
        u32x4 o; o.x = pk2(s[0 * 33], s[1 * 33]); o.y = pk2(s[2 * 33], s[3 * 33]); o.z = pk2(s[4 * 33], s[5 * 33]); o.w = pk2(s[6 * 33], s[7 * 33]);
        *(u32x4*)(WT + (size_t)(r0 + n) * K + k0 + 8 * c) = o; }
    LDS_WAIT(); asm volatile("" ::: "memory");
}
__device__ __forceinline__ void convert_weights(ArgsP a, int l, int which, LAS unsigned char* lds, int gw, int NGW, int wave, int lane) {
    LAS float* scr = (LAS float*)(lds + wave * 16384);
    bf16_t* WB = (bf16_t*)(a->ws + WS_W);
    constexpr int IT_IN = (D / 64) * (PIN / 32), IT_SQ = (D / 64) * (D / 32), IT_1 = (D / 64) * (FF / 32), IT_2 = (FF / 64) * (D / 32);
    const int n_in = (which & 1) ? IT_IN : 0, n_c = (which & 2) ? IT_SQ : 0, n_a = n_c, n_o = (which & 4) ? IT_SQ : 0, n_1 = (which & 8) ? IT_1 : 0, n_2 = (which & 16) ? IT_2 : 0;
    const int total = n_in + n_c + n_a + n_o + n_1 + n_2;
#pragma unroll 1
    for (int it = gw; it < total; it += NGW) {
        int r = it;
        if (r < n_in) { transpose_item(a->in[I_WIN] + (size_t)l * D * PIN, D, PIN, WB + WE_IN, 0, true, scr, r, lane); continue; } r -= n_in;
        if (r < n_c) { transpose_item(a->in[I_WBC] + (size_t)l * D * D, D, D, WB + WE_CA, 0, false, scr, r, lane); continue; } r -= n_c;
        if (r < n_a) { transpose_item(a->in[I_WBA] + (size_t)l * D * D, D, D, WB + WE_CA, 1024, false, scr, r, lane); continue; } r -= n_a;
        if (r < n_o) { transpose_item(a->in[I_WO] + (size_t)l * D * D, D, D, WB + WE_O, 0, false, scr, r, lane); continue; } r -= n_o;
        if (r < n_1) { transpose_item(a->in[I_WFF1] + (size_t)l * D * FF, D, FF, WB + WE_1, 0, false, scr, r, lane); continue; } r -= n_1;
        transpose_item(a->in[I_WFF2] + (size_t)l * FF * D, FF, D, WB + WE_2, 0, false, scr, r, lane);
    }
}

__device__ __forceinline__ void mod_item(ArgsP a, int item, LAS unsigned char* lds, int tid) {
    const int l = item / 128, col0 = (item % 128) * 48;
    LAS float* sc = (LAS float*)lds;
    const float* W = a->in[I_WADA] + (size_t)l * D * (NMOD * D);
    const int col = tid % 48, rg = tid / 48;
    const bool active = rg < 10;
    float acc[14];
#pragma unroll
    for (int r = 0; r < 14; ++r) acc[r] = 0.f;
    for (int ch = 0; ch < 8; ++ch) {
        __syncthreads();
        for (int idx = tid; idx < NMROW * 128; idx += NTHR) { const int row = idx >> 7, dd = idx & 127;
            const float c = row < NB ? a->in[I_CP][row * D + ch * 128 + dd] : a->in[I_CS][(row - NB) * D + ch * 128 + dd];
            sc[row * 132 + dd] = c * __builtin_amdgcn_rcpf(1.0f + __builtin_amdgcn_exp2f(-c * LOG2E)); }
        __syncthreads();
        if (active) {
            for (int d4 = 0; d4 < 32; ++d4) {
                const float* wp = W + (size_t)(ch * 128 + d4 * 4) * (NMOD * D) + col0 + col;
                const float w0 = wp[0], w1 = wp[NMOD * D], w2 = wp[2 * NMOD * D], w3 = wp[3 * NMOD * D];
#pragma unroll
                for (int r = 0; r < 14; ++r) { const int row = rg * 14 + r; const int rr = row < NMROW ? row : NMROW - 1;
                    const f32x4 s = *(const LAS f32x4*)(sc + rr * 132 + d4 * 4);
                    acc[r] += s[0] * w0 + s[1] * w1 + s[2] * w2 + s[3] * w3; }
            }
        }
    }
    if (active) {
        float* mod = (float*)(a->ws + WS_MOD) + (size_t)l * NMROW * (NMOD * D);
        const float bb = a->in[I_BADA][l * NMOD * D + col0 + col];
#pragma unroll
        for (int r = 0; r < 14; ++r) { const int row = rg * 14 + r; if (row < NMROW) mod[(size_t)row * (NMOD * D) + col0 + col] = acc[r] + bb; }
    }
    __syncthreads();
}

__device__ __forceinline__ int t5_bucket(int n) {
    if (n < 16) return n;
    const float v = logf((float)n / 16.0f) / 2.0794415416798357f * 16.0f;
    int b = 16 + (int)v; return b < 31 ? b : 31;
}

__device__ __forceinline__ int mod_row(int m) { return m < MP ? (m >> 12) : NB + ((m - MP) >> 3); }
__device__ __forceinline__ void modnorm_store(const f32x4 (&v)[4], float ss, const float* g, const float* sh, const float* sc, bf16_t* hrow, int lane) {
    const float rstd = 1.0f / sqrtf(ss * (1.0f / D) + RMS_EPS);
#pragma unroll
    for (int j = 0; j < 4; ++j) { const int c = 4 * lane + 256 * j;
        const f32x4 gg = *(const f32x4*)(g + c), s1 = *(const f32x4*)(sc + c), s0 = *(const f32x4*)(sh + c);
        const f32x4 y = (v[j] * rstd * gg) * (s1 + 1.0f) + s0;
        u32x2 o; o.x = cvt_pk_bf16(y[0], y[1]); o.y = cvt_pk_bf16(y[2], y[3]); *(u32x2*)(hrow + c) = o; }
}
__device__ __forceinline__ float sumsq4(const f32x4 (&v)[4]) { float s = 0.f;
#pragma unroll
    for (int j = 0; j < 4; ++j) s += (v[j][0] * v[j][0] + v[j][1] * v[j][1]) + (v[j][2] * v[j][2] + v[j][3] * v[j][3]);
    return wave_sum(s); }

namespace att {
constexpr int LDS_K = 0, LDS_V = 32768, LDS_BIAS = 65536;
__device__ __forceinline__ int crow(int r, int hi) { return (r & 3) + 8 * (r >> 2) + 4 * hi; }
__device__ __forceinline__ s16x4 vtr(const LAS unsigned char* p) { return __builtin_bit_cast(s16x4, __builtin_amdgcn_ds_read_tr16_b64_v4i16((LAS s16x4*)p)); }
__device__ __forceinline__ u32x4 pack8(const float* p) { const f32x4 a = *(const f32x4*)p, b = *(const f32x4*)(p + 4); u32x4 w; w.x = pk2(a[0], a[1]); w.y = pk2(a[2], a[3]); w.z = pk2(b[0], b[1]); w.w = pk2(b[2], b[3]); return w; }

__device__ __forceinline__ void unit(LAS unsigned char* lds, bf16_t* proj, const float* biasT, const float* sinks_l, int kh, bool is_sample, int qrow0, int krow0, bool first_blk,
                                     const float* ck, const float* cv, int tid, int wave, int lane) {
    __syncthreads();
    if (!is_sample) {
        const int kbeg = first_blk ? 128 : 0;
#pragma unroll 1
        for (int idx = kbeg * 8 + tid; idx < 256 * 8; idx += NTHR) { const int kap = idx >> 3, ch = idx & 7;
            const bf16_t* src = proj + (size_t)(krow0 + kap) * LD + PC_K + kh * 64 + ch * 8;
            const u32x4 kv = *(const u32x4*)src, vv = *(const u32x4*)(src + (PC_V - PC_K));
            *(LAS u32x4*)(lds + LDS_K + kap * 128 + ((ch ^ (kap & 7)) << 4)) = kv;
            *(LAS u32x4*)(lds + LDS_V + kap * 128 + (ch << 4)) = vv; }
    } else {
#pragma unroll 1
        for (int idx = tid; idx < 128 * 8; idx += NTHR) { const int kap = idx >> 3, ch = idx & 7;
            const u32x4 kv = pack8(ck + kap * 128 + kh * 64 + ch * 8), vv = pack8(cv + kap * 128 + kh * 64 + ch * 8);
            *(LAS u32x4*)(lds + LDS_K + kap * 128 + ((ch ^ (kap & 7)) << 4)) = kv;
            *(LAS u32x4*)(lds + LDS_V + kap * 128 + (ch << 4)) = vv; }
        if (tid < 256) { const int kap = 128 + (tid >> 3), ch = tid & 7;
            const bf16_t* src = proj + (size_t)(qrow0 + ((tid >> 3) & 7)) * LD + PC_K + kh * 64 + ch * 8;
            u32x4 kv = *(const u32x4*)src, vv = *(const u32x4*)(src + (PC_V - PC_K));
            const bool z = kap >= 136; const u32x4 zero = {0u, 0u, 0u, 0u}; kv = z ? zero : kv; vv = z ? zero : vv;
            *(LAS u32x4*)(lds + LDS_K + kap * 128 + ((ch ^ (kap & 7)) << 4)) = kv;
            *(LAS u32x4*)(lds + LDS_V + kap * 128 + (ch << 4)) = vv; }
    }
    LAS float* biasL = (LAS float*)(lds + LDS_BIAS);
#pragma unroll 1
    for (int idx = tid; idx < 8 * 128; idx += NTHR) biasL[idx] = biasT[kh * 8 * 128 + idx];
    __syncthreads();
    const int h = kh * 8 + wave, r32 = lane & 31, hi = lane >> 5;
    const float sinkL = sinks_l[h] * LOG2E;
    const LAS unsigned char* vbase = lds + LDS_V + (4 * hi + ((lane & 15) >> 2)) * 128 + (16 * ((lane >> 4) & 1) + 4 * (lane & 3)) * 2;
    const LAS float* bw = biasL + wave * 128;
    const int nqt = is_sample ? 1 : 4;
#pragma unroll 1
    for (int i = 0; i < nqt; ++i) {
        const int qr = is_sample ? qrow0 + (r32 & 7) : qrow0 + 32 * i + r32;
        bf16_t* qp = proj + (size_t)qr * LD + PC_Q + h * 64;
        bf16x8 qf[4];
#pragma unroll
        for (int ks = 0; ks < 4; ++ks) qf[ks] = *(const bf16x8*)(qp + 16 * ks + 8 * hi);
        f32x16 p[5];
#pragma unroll
        for (int j = 0; j < 5; ++j) {
            const int jt = i + j; const bool skip = first_blk && jt < 4;
            f32x16 acc;
#pragma unroll
            for (int r = 0; r < 16; ++r) acc[r] = 0.f;
            if (!skip) {
#pragma unroll
                for (int ks = 0; ks < 4; ++ks) { const bf16x8 kf = *(const LAS bf16x8*)(lds + LDS_K + (32 * jt + r32) * 128 + (((2 * ks + hi) ^ (r32 & 7)) << 4));
                    acc = __builtin_amdgcn_mfma_f32_32x32x16_bf16(kf, qf[ks], acc, 0, 0, 0); }
#pragma unroll
                for (int r = 0; r < 16; ++r) { const int dd = 128 - 32 * j + r32 - crow(r, hi); const bool valid = (unsigned)dd < 128u;
                    const float b = bw[dd & 127]; acc[r] = valid ? acc[r] + b : NEG; }
            } else {
#pragma unroll
                for (int r = 0; r < 16; ++r) acc[r] = NEG;
            }
            p[j] = acc;
        }
        float mx = sinkL;
#pragma unroll
        for (int j = 0; j < 5; ++j)
#pragma unroll
            for (int r = 0; r < 16; ++r) mx = fmaxf(mx, p[j][r]);
        mx = fmaxf(mx, __shfl_xor(mx, 32));
        float sum = 0.f;
#pragma unroll
        for (int j = 0; j < 5; ++j)
#pragma unroll
            for (int r = 0; r < 16; ++r) { const float e = __builtin_amdgcn_exp2f(p[j][r] - mx); p[j][r] = e; sum += e; }
        sum += __shfl_xor(sum, 32);
        const float inv = 1.0f / (sum + __builtin_amdgcn_exp2f(sinkL - mx));
        f32x16 o0, o1;
#pragma unroll
        for (int r = 0; r < 16; ++r) { o0[r] = 0.f; o1[r] = 0.f; }
#pragma unroll
        for (int j = 0; j < 5; ++j) {
            const int jt = i + j; const bool skip = first_blk && jt < 4;
            if (!skip) {
#pragma unroll
                for (int s = 0; s < 2; ++s) {
                    u32x4 pw; pw.x = cvt_pk_bf16(p[j][8 * s + 0], p[j][8 * s + 1]); pw.y = cvt_pk_bf16(p[j][8 * s + 2], p[j][8 * s + 3]);
                    pw.z = cvt_pk_bf16(p[j][8 * s + 4], p[j][8 * s + 5]); pw.w = cvt_pk_bf16(p[j][8 * s + 6], p[j][8 * s + 7]);
                    const bf16x8 pf = __builtin_bit_cast(bf16x8, pw);
                    const LAS unsigned char* vp = vbase + (32 * jt + 16 * s) * 128;
                    const s16x4 a0 = vtr(vp), a1 = vtr(vp + 8 * 128), b0 = vtr(vp + 64), b1 = vtr(vp + 8 * 128 + 64);
                    const bf16x8 vf0 = {a0[0], a0[1], a0[2], a0[3], a1[0], a1[1], a1[2], a1[3]}, vf1 = {b0[0], b0[1], b0[2], b0[3], b1[0], b1[1], b1[2], b1[3]};
                    o0 = __builtin_amdgcn_mfma_f32_32x32x16_bf16(vf0, pf, o0, 0, 0, 0);
                    o1 = __builtin_amdgcn_mfma_f32_32x32x16_bf16(vf1, pf, o1, 0, 0, 0);
                }
            }
        }
        if (!is_sample || r32 < 8) {
#pragma unroll
            for (int g4 = 0; g4 < 4; ++g4) {
                u32x2 w0, w1;
                w0.x = cvt_pk_bf16(o0[4 * g4] * inv, o0[4 * g4 + 1] * inv); w0.y = cvt_pk_bf16(o0[4 * g4 + 2] * inv, o0[4 * g4 + 3] * inv);
                w1.x = cvt_pk_bf16(o1[4 * g4] * inv, o1[4 * g4 + 1] * inv); w1.y = cvt_pk_bf16(o1[4 * g4 + 2] * inv, o1[4 * g4 + 3] * inv);
                *(u32x2*)(qp + 8 * g4 + 4 * hi) = w0; *(u32x2*)(qp + 32 + 8 * g4 + 4 * hi) = w1;
            }
        }
    }
}
}

#define WSP(T, off) ((T*)(a->ws + (off)))
__global__ void __launch_bounds__(NTHR, 2) trunk_fwd(Args kargs) {
    extern __shared__ __attribute__((aligned(16))) unsigned char lds_raw[];
    LAS unsigned char* lds = (LAS unsigned char*)lds_raw;
    volatile LAS unsigned* MISC = (volatile LAS unsigned*)(lds + MISC_OFF);
    const int G = gridDim.x, bx = blockIdx.x;
    const int vcu = (G % 8 == 0) ? (bx % 8) * (G / 8) + bx / 8 : bx;
    for (int u = threadIdx.x; u < (LDS_BYTES - LDSCTL_OFF) / 4; u += NTHR) ((LAS unsigned*)(lds + LDSCTL_OFF))[u] = 0u;
    __syncthreads();
    XcdBarrier bar; bar.bar = nullptr; bar.x = 0; bar.st = MISC + 8;
    if (!MK_PER_PHASE_LAUNCH) { ArgsP a = args_ptr(); bar = xcd_barrier_post((unsigned*)(a->ws + WS_CTL) + CW_BAR, MISC + 8); }
    const int ph_lo = kargs.ph_lo, ph_hi = kargs.ph_hi;

    for (int ph = ph_lo; ph < ph_hi; ++ph) {
        ArgsP a = args_ptr();
        int tid = threadIdx.x; asm volatile("" : "+v"(tid));
        const int lane = tid & 63, wave = __builtin_amdgcn_readfirstlane(tid >> 6);
        const int gw = vcu * NWAVES + wave, NGW = G * NWAVES;
        if (ph == 0 && (PHMASK & 1)) {
            for (int it = bx; it < 256; it += G) mod_item(a, it, lds, tid);
            if (bx == G - 1) { float* BIAS = WSP(float, WS_BIAS); const float* rel = a->in[I_REL];
                for (int idx = tid; idx < NH * 128; idx += NTHR) { const int hh = idx >> 7, dd = idx & 127; BIAS[idx] = rel[t5_bucket(dd) * NH + hh] * LOG2E; } }
            __syncthreads();
            convert_weights(a, 0, 31, lds, gw, NGW, wave, lane);
        } else if (ph == 1 && (PHMASK & 2)) {
            const float* xp = a->in[I_XP]; const float* xs = a->in[I_XS]; const float* MOD = WSP(float, WS_MOD); bf16_t* H = WSP(bf16_t, WS_H); const float* g1 = a->in[I_GPRE1];
#pragma unroll 1
            for (int m = gw; m < M; m += NGW) {
                const float* xr = m < MP ? xp + (size_t)m * D : xs + (size_t)(m - MP) * D;
                f32x4 v[4];
#pragma unroll
                for (int j = 0; j < 4; ++j) v[j] = *(const f32x4*)(xr + 4 * lane + 256 * j);
                const float* mr = MOD + (size_t)mod_row(m) * (NMOD * D);
                modnorm_store(v, sumsq4(v), g1, mr, mr + D, H + (size_t)m * D, lane);
            }
        } else if (ph >= 2) {
            const int l = (ph - 2) >> 3, sp = (ph - 2) & 7;
            if (sp == 0 && (PHMASK & 4)) {
                pg8::Gemm g{WSP(bf16_t, WS_H), WSP(bf16_t, WS_W) + WE_IN, D, D, 0, 0}; pg8::StaticOrder S; S.init(M, PIN, G, bx, 0);
                pg8::Epi<pg8::EPI_PROJ> E{WSP(bf16_t, WS_PROJ), nullptr, 0};
                pg8::gemm_phase(lds, g, S, E, tid);
            } else if (sp == 1 && (PHMASK & 8)) {
                bf16_t* PROJ = WSP(bf16_t, WS_PROJ);
                {
                    const float* sinks_l = a->in[I_SINKS] + l * NH; const float* BIAS = WSP(float, WS_BIAS);
                    const float* ck = a->in[I_CK] + (size_t)l * NS * 128 * 128; const float* cv = a->in[I_CV] + (size_t)l * NS * 128 * 128;
                    for (int u = bx; u < 512; u += G) {
                        if (u < 256) { const int kh = u & 1, blk = u >> 1, b = blk >> 5, qb = blk & 31; const int qrow0 = b * SEQ + qb * 128;
                            att::unit(lds, PROJ, BIAS, sinks_l, kh, false, qrow0, qrow0 - 128, qb == 0, nullptr, nullptr, tid, wave, lane);
                        } else { const int v = u - 256, kh = v & 1, n = v >> 1;
                            att::unit(lds, PROJ, BIAS, sinks_l, kh, true, MP + n * TS, 0, false, ck + (size_t)n * 128 * 128, cv + (size_t)n * 128 * 128, tid, wave, lane); }
                    }
                }
                __syncthreads();
                const int gt = vcu * NTHR + tid, NGT = G * NTHR;
                {
                    const float* cw = a->in[I_CONVW] + (size_t)l * 3 * D; const float* scv = a->in[I_SCONV] + (size_t)l * NS * 2 * D; float* outp = a->out;
#pragma unroll 1
                    for (int it = gt; it < M * 128; it += NGT) {
                        const int m = it >> 7, c8 = (it & 127) * 8;
                        const bool smp = m >= MP; const int t = smp ? ((m - MP) & 7) : (m & (SEQ - 1)); const int n = smp ? ((m - MP) >> 3) : 0;
                        bf16_t* rp = PROJ + (size_t)m * LD;
                        const u32x4 bg = *(const u32x4*)(rp + PC_BG + c8), u2 = *(const u32x4*)(rp + PC_U + c8);
                        const u32x4 u1 = *(const u32x4*)(rp - (t >= 1 ? LD : 0) + PC_U + c8), u0 = *(const u32x4*)(rp - (t >= 2 ? 2 * LD : 0) + PC_U + c8);
                        const float* s1 = scv + ((size_t)n * 2 + 1) * D + c8; const float* s0 = scv + ((size_t)n * 2 + (t & 1)) * D + c8;
                        const f32x4 p1a = *(const f32x4*)s1, p1b = *(const f32x4*)(s1 + 4), p0a = *(const f32x4*)s0, p0b = *(const f32x4*)(s0 + 4);
                        const float x2[8] = {bf_lo(u2.x), bf_hi(u2.x), bf_lo(u2.y), bf_hi(u2.y), bf_lo(u2.z), bf_hi(u2.z), bf_lo(u2.w), bf_hi(u2.w)};
                        const float q1[8] = {bf_lo(u1.x), bf_hi(u1.x), bf_lo(u1.y), bf_hi(u1.y), bf_lo(u1.z), bf_hi(u1.z), bf_lo(u1.w), bf_hi(u1.w)};
                        const float q0[8] = {bf_lo(u0.x), bf_hi(u0.x), bf_lo(u0.y), bf_hi(u0.y), bf_lo(u0.z), bf_hi(u0.z), bf_lo(u0.w), bf_hi(u0.w)};
                        const float r1[8] = {p1a[0], p1a[1], p1a[2], p1a[3], p1b[0], p1b[1], p1b[2], p1b[3]}, r0[8] = {p0a[0], p0a[1], p0a[2], p0a[3], p0b[0], p0b[1], p0b[2], p0b[3]};
                        const float bgf[8] = {bf_lo(bg.x), bf_hi(bg.x), bf_lo(bg.y), bf_hi(bg.y), bf_lo(bg.z), bf_hi(bg.z), bf_lo(bg.w), bf_hi(bg.w)};
                        const f32x4 wa0 = *(const f32x4*)(cw + c8), wb0 = *(const f32x4*)(cw + c8 + 4), wa1 = *(const f32x4*)(cw + D + c8), wb1 = *(const f32x4*)(cw + D + c8 + 4), wa2 = *(const f32x4*)(cw + 2 * D + c8), wb2 = *(const f32x4*)(cw + 2 * D + c8 + 4);
                        const float w0[8] = {wa0[0], wa0[1], wa0[2], wa0[3], wb0[0], wb0[1], wb0[2], wb0[3]}, w1[8] = {wa1[0], wa1[1], wa1[2], wa1[3], wb1[0], wb1[1], wb1[2], wb1[3]}, w2[8] = {wa2[0], wa2[1], wa2[2], wa2[3], wb2[0], wb2[1], wb2[2], wb2[3]};
                        float y[8];
#pragma unroll
                        for (int e = 0; e < 8; ++e) { const float x1 = t >= 1 ? q1[e] : (smp ? r1[e] : 0.f), x0 = t >= 2 ? q0[e] : (smp ? r0[e] : 0.f);
                            y[e] = bgf[e] * (w0[e] * x0 + w1[e] * x1 + w2[e] * x2[e]); }
                        u32x4 o; o.x = cvt_pk_bf16(y[0], y[1]); o.y = cvt_pk_bf16(y[2], y[3]); o.z = cvt_pk_bf16(y[4], y[5]); o.w = cvt_pk_bf16(y[6], y[7]);
                        *(u32x4*)(rp + PC_BG + c8) = o;
                        const int tl = smp ? t - (TS - 2) : t - (SEQ - 2);
                        if (tl >= 0) { float* op = outp + (smp ? O_CONVS + (((size_t)l * NS + n) * 2 + tl) * D : O_CONVP + (((size_t)l * NB + (m >> 12)) * 2 + tl) * D) + c8;
                            *(f32x4*)op = (f32x4){x2[0], x2[1], x2[2], x2[3]}; *(f32x4*)(op + 4) = (f32x4){x2[4], x2[5], x2[6], x2[7]}; }
                    }
                }
                {
                    float* outp = a->out;
#pragma unroll 1
                    for (int it = gt; it < NB * 128 * 32; it += NGT) {
                        const int c8 = (it & 31) * 8, rr = it >> 5, b = rr >> 7, p = rr & 127;
                        const u32x4 w = *(const u32x4*)(PROJ + (size_t)(b * SEQ + SEQ - 128 + p) * LD + PC_K + c8);
                        float* op = outp + (c8 < 128 ? O_KP : O_VP) + (((size_t)l * NB + b) * 128 + p) * 128 + (c8 & 127);
                        *(f32x4*)op = (f32x4){bf_lo(w.x), bf_hi(w.x), bf_lo(w.y), bf_hi(w.y)}; *(f32x4*)(op + 4) = (f32x4){bf_lo(w.z), bf_hi(w.z), bf_lo(w.w), bf_hi(w.w)};
                    }
                    const float* ck = a->in[I_CK] + (size_t)l * NS * 128 * 128; const float* cv = a->in[I_CV] + (size_t)l * NS * 128 * 128;
#pragma unroll 1
                    for (int it = gt; it < NS * 120 * 32; it += NGT) {
                        const int c8 = (it & 31) * 8, rr = it >> 5, n = rr / 120, p = rr - n * 120; const bool isv = c8 >= 128; const int c = c8 & 127;
                        float* op = outp + (isv ? O_VS : O_KS) + (((size_t)l * NS + n) * 128 + p) * 128 + c;
                        const float* sp_ = (isv ? cv : ck) + ((size_t)n * 128 + p + 8) * 128 + c; *(f32x4*)op = *(const f32x4*)sp_; *(f32x4*)(op + 4) = *(const f32x4*)(sp_ + 4);
                    }
#pragma unroll 1
                    for (int it = gt; it < NS * 8 * 32; it += NGT) {
                        const int c8 = (it & 31) * 8, rr = it >> 5, n = rr >> 3, p = rr & 7; const bool isv = c8 >= 128; const int c = c8 & 127;
                        float* op = outp + (isv ? O_VS : O_KS) + (((size_t)l * NS + n) * 128 + 120 + p) * 128 + c;
                        const u32x4 w = *(const u32x4*)(PROJ + (size_t)(MP + n * TS + p) * LD + PC_K + c8);
                        *(f32x4*)op = (f32x4){bf_lo(w.x), bf_hi(w.x), bf_lo(w.y), bf_hi(w.y)}; *(f32x4*)(op + 4) = (f32x4){bf_lo(w.z), bf_hi(w.z), bf_lo(w.w), bf_hi(w.w)};
                    }
                }
                if (l == 0) { __syncthreads(); convert_weights(a, 1, 1, lds, gw, NGW, wave, lane); }
            } else if (sp == 2 && (PHMASK & 16)) {
                pg8::Gemm g{WSP(bf16_t, WS_PROJ) + PC_BG, WSP(bf16_t, WS_W) + WE_CA, LD, D, (size_t)(PC_Q - PC_BG) * 2, (size_t)D * D * 2}; pg8::StaticOrder S; S.init(M, D, G, bx, 1);
                pg8::Epi<pg8::EPI_BRANCH> E{WSP(bf16_t, WS_PROJ), WSP(bf16_t, WS_H), D};
                pg8::gemm_phase(lds, g, S, E, tid);
            } else if (sp == 3 && (PHMASK & 32)) {
                pg8::Gemm g{WSP(bf16_t, WS_H), WSP(bf16_t, WS_W) + WE_O, D, D, 0, 0}; pg8::StaticOrder S; S.init(M, D, G, bx, 0);
                pg8::Epi<pg8::EPI_F32> E{nullptr, WSP(float, WS_PROJ), D};
                pg8::gemm_phase(lds, g, S, E, tid);
            } else if (sp == 4 && (PHMASK & 64)) {
                const float* gp = a->in[I_GPOST1] + l * D; const float* g2 = a->in[I_GPRE2] + l * D; float* XO = a->out; const float* MIXED = WSP(float, WS_PROJ); bf16_t* H = WSP(bf16_t, WS_H);
                const float* MODL = WSP(float, WS_MOD) + (size_t)l * NMROW * (NMOD * D);
                const float* xp = l == 0 ? a->in[I_XP] : XO; const float* xs = l == 0 ? a->in[I_XS] : XO + (size_t)MP * D;
    #pragma unroll 1
            for (int m = gw; m < M; m += NGW) {
                    const float* xr = m < MP ? xp + (size_t)m * D : xs + (size_t)(m - MP) * D;
                    const float* yr = MIXED + (size_t)m * D; const float* mr = MODL + (size_t)mod_row(m) * (NMOD * D);
                    f32x4 v[4], y[4];
#pragma unroll
                    for (int j = 0; j < 4; ++j) { v[j] = *(const f32x4*)(xr + 4 * lane + 256 * j); y[j] = *(const f32x4*)(yr + 4 * lane + 256 * j); }
                    const float rstd = 1.0f / sqrtf(sumsq4(y) * (1.0f / D) + RMS_EPS);
#pragma unroll
                    for (int j = 0; j < 4; ++j) { const int c = 4 * lane + 256 * j; const f32x4 ga = *(const f32x4*)(mr + 2 * D + c), gg = *(const f32x4*)(gp + c);
                        v[j] = v[j] + ga * (y[j] * rstd * gg); *(f32x4*)(XO + (size_t)m * D + c) = v[j]; }
                    modnorm_store(v, sumsq4(v), g2, mr + 3 * D, mr + 4 * D, H + (size_t)m * D, lane);
                }
                if (l == 0) { __syncthreads(); convert_weights(a, 1, 2 | 4, lds, gw, NGW, wave, lane); }
            } else if (sp == 5 && (PHMASK & 128)) {
                pg8::Gemm g{WSP(bf16_t, WS_H), WSP(bf16_t, WS_W) + WE_1, D, D, 0, 0}; pg8::StaticOrder S; S.init(M, FF, G, bx, 0);
                pg8::Epi<pg8::EPI_RELU2> E{nullptr, WSP(bf16_t, WS_PROJ), FF};
                pg8::gemm_phase(lds, g, S, E, tid);
            } else if (sp == 6 && (PHMASK & 256)) {
                pg8::Gemm g{WSP(bf16_t, WS_PROJ), WSP(bf16_t, WS_W) + WE_2, FF, FF, 0, 0}; pg8::StaticOrder S; S.init(M, D, G, bx, 0);
                pg8::Epi<pg8::EPI_BF16> E{nullptr, WSP(bf16_t, WS_PROJ + PROJ_FFO), D};
                pg8::gemm_phase(lds, g, S, E, tid);
            } else if (sp == 7 && (PHMASK & 512)) {
                const float* gp = a->in[I_GPOST2] + l * D; float* XO = a->out; const bf16_t* FFO = WSP(bf16_t, WS_PROJ + PROJ_FFO); bf16_t* H = WSP(bf16_t, WS_H);
                const float* MODL = WSP(float, WS_MOD) + (size_t)l * NMROW * (NMOD * D);
                const float* MODN = WSP(float, WS_MOD) + (size_t)1 * NMROW * (NMOD * D); const float* g1n = a->in[I_GPRE1] + D;
    #pragma unroll 1
            for (int m = gw; m < M; m += NGW) {
                    float* xr = XO + (size_t)m * D; const bf16_t* yr = FFO + (size_t)m * D; const float* mr = MODL + (size_t)mod_row(m) * (NMOD * D);
                    f32x4 v[4], y[4];
#pragma unroll
                    for (int j = 0; j < 4; ++j) { v[j] = *(const f32x4*)(xr + 4 * lane + 256 * j); const u32x2 w = *(const u32x2*)(yr + 4 * lane + 256 * j); y[j] = (f32x4){bf_lo(w.x), bf_hi(w.x), bf_lo(w.y), bf_hi(w.y)}; }
                    const float rstd = 1.0f / sqrtf(sumsq4(y) * (1.0f / D) + RMS_EPS);
#pragma unroll
                    for (int j = 0; j < 4; ++j) { const int c = 4 * lane + 256 * j; const f32x4 ga = *(const f32x4*)(mr + 5 * D + c), gg = *(const f32x4*)(gp + c);
                        v[j] = v[j] + ga * (y[j] * rstd * gg); *(f32x4*)(xr + c) = v[j]; }
                    if (l == 0) { const float* mn = MODN + (size_t)mod_row(m) * (NMOD * D); modnorm_store(v, sumsq4(v), g1n, mn, mn + D, H + (size_t)m * D, lane); }
                }
                if (l == 0) { __syncthreads(); convert_weights(a, 1, 8 | 16, lds, gw, NGW, wave, lane); }
            }
        }
        if (ph + 1 < ph_hi) xcd_barrier(bar);
    }
}

extern "C" void kernel_launch(void* const* d_in, const int* in_sizes, int n_in, void* d_out, int out_size, void* d_ws, size_t ws_size, hipStream_t stream) {
    static int grid = 0;
    if (grid == 0) {
        if (n_in != 22 || (size_t)out_size != O_END || ws_size < WS_END) { fprintf(stderr, "kernel_launch: unexpected shapes (n_in %d out %d ws %zu); nothing launched\n", n_in, out_size, ws_size); grid = -1; return; }
        int dev = 0, cus = 0, per_cu = 0;
        if (hipGetDevice(&dev) != hipSuccess || hipDeviceGetAttribute(&cus, hipDeviceAttributeMultiprocessorCount, dev) != hipSuccess) { grid = -1; return; }
        if (hipFuncSetAttribute((const void*)trunk_fwd, hipFuncAttributeMaxDynamicSharedMemorySize, LDS_BYTES) != hipSuccess) { fprintf(stderr, "kernel_launch: hipFuncSetAttribute failed\n"); grid = -1; return; }
        if (hipOccupancyMaxActiveBlocksPerMultiprocessor(&per_cu, (const void*)trunk_fwd, NTHR, LDS_BYTES) != hipSuccess || per_cu < 1) { fprintf(stderr, "kernel_launch: occupancy query says %d\n", per_cu); per_cu = 1; }
        (void)hipGetLastError();
        grid = cus;
    }
    if (grid < 0) return;
    if (hipMemsetAsync((char*)d_ws + WS_CTL, 0, CTL_ZERO_BYTES, stream) != hipSuccess) return;
    Args a{};
    for (int i = 0; i < 22; ++i) a.in[i] = (const float*)d_in[i];
    a.out = (float*)d_out; a.ws = (unsigned char*)d_ws;
#if MK_PER_PHASE_LAUNCH
    for (int ph = 0; ph < NPHASE; ++ph) { a.ph_lo = ph; a.ph_hi = ph + 1; hipLaunchKernelGGL(trunk_fwd, dim3(grid), dim3(NTHR), LDS_BYTES, stream, a); }
#else
    a.ph_lo = 0; a.ph_hi = NPHASE;
    hipLaunchKernelGGL(trunk_fwd, dim3(grid), dim3(NTHR), LDS_BYTES, stream, a);
#endif
}
```

```cpp
#include <hip/hip_runtime.h>
#include <cstdio>
#include <cstdint>

#define LAS __attribute__((address_space(3)))
#define GAS __attribute__((address_space(1)))
typedef unsigned short bf16_t;
typedef short bf16x8 __attribute__((ext_vector_type(8)));
typedef short s16x4 __attribute__((ext_vector_type(4)));
typedef float f32x2 __attribute__((ext_vector_type(2)));
typedef float f32x4 __attribute__((ext_vector_type(4)));
typedef float f32x16 __attribute__((ext_vector_type(16)));
typedef unsigned u32x2 __attribute__((ext_vector_type(2)));
typedef unsigned u32x4 __attribute__((ext_vector_type(4)));
typedef __bf16 bf16x2_t __attribute__((ext_vector_type(2)));

#ifndef PHMASK
#define PHMASK 1023
#endif
#ifndef MK_PER_PHASE_LAUNCH
#define MK_PER_PHASE_LAUNCH 0
#endif

constexpr int D = 1024, SEQ = 4096, NB = 4, NS = 128, TS = 8, NH = 16, HD = 64, FF = 4096, NMOD = 6;
constexpr int MP = NB * SEQ, MS = NS * TS, M = MP + MS;
constexpr int NMROW = NB + NS;
constexpr int PIN = 6400;
constexpr int LD = 5376;
constexpr int PC_BG = 0, PC_U = 1024, PC_Q = 2048, PC_K = 3072, PC_V = 3200, PC_G = 3328;
constexpr float RMS_EPS = 1e-6f, LOG2E = 1.4426950408889634f, QSCALE = 0.125f * 1.4426950408889634f, NEG = -1e30f;

enum { I_XP = 0, I_XS, I_CP, I_CS, I_SCONV, I_CK, I_CV, I_WADA, I_BADA, I_GPRE1, I_WIN, I_CONVW, I_WBC, I_WBA, I_WO, I_SINKS, I_GPOST1, I_GPRE2, I_WFF1, I_WFF2, I_GPOST2, I_REL };
constexpr size_t O_YP = 0, O_YS = (size_t)MP * D, O_CONVP = O_YS + (size_t)MS * D, O_KP = O_CONVP + 2 * NB * 2 * D, O_VP = O_KP + 2 * NB * 128 * 128,
                 O_CONVS = O_VP + 2 * NB * 128 * 128, O_KS = O_CONVS + 2 * NS * 2 * D, O_VS = O_KS + (size_t)2 * NS * 128 * 128, O_END = O_VS + (size_t)2 * NS * 128 * 128;

constexpr size_t KiB = 1024, MiB = 1u << 20;
constexpr size_t WS_CTL = 0, CTL_ZERO_BYTES = 256 * KiB;
constexpr size_t WS_W = 512 * KiB;
constexpr size_t WE_IN = 0, WE_CA = (size_t)PIN * D, WE_O = WE_CA + 2048 * (size_t)D, WE_1 = WE_O + (size_t)D * D, WE_2 = WE_1 + (size_t)FF * D, WE_END = WE_2 + (size_t)D * FF;
constexpr size_t WS_MOD = WS_W + 35 * MiB;
constexpr size_t WS_BIAS = WS_MOD + (size_t)2 * NMROW * NMOD * D * 4;
constexpr size_t WS_H = WS_W + 35 * MiB + 6 * MiB + 256 * KiB;
constexpr size_t WS_PROJ = WS_H + (size_t)M * D * 2;
constexpr size_t WS_END = WS_PROJ + (size_t)M * LD * 2;
static_assert(WE_END * 2 <= 35 * MiB && WS_BIAS + 16 * 128 * 4 <= WS_H && WS_END <= 256 * MiB, "d_ws map");
constexpr size_t PROJ_FFO = (size_t)M * FF * 2;
static_assert(PROJ_FFO + (size_t)M * D * 2 <= (size_t)M * LD * 2, "FFO overlay");

namespace pg8 {
constexpr int BM = 256, BK = 64, HALF = 128, HTB = HALF * BK * 2, STAGE_BYTES = 8 * HTB, NXCD = 8, WGM = 8;
__host__ __device__ __forceinline__ int lds_byte(int r, int c) { const int st = (r >> 4) * 2 + (c >> 5), rr = r & 15, cc = c & 31, ob = rr * 64 + cc * 2; return st * 1024 + (ob ^ (((ob >> 9) & 1) << 5)); }
__host__ __device__ __forceinline__ void stage_rc(int b, int& R, int& C) { const int st = b / 1024, sb = b % 1024, swz = sb ^ (((sb >> 9) & 1) << 5); R = (st >> 1) * 16 + swz / 64; C = (st & 1) * 32 + (swz % 64) / 2; }
__host__ __device__ __forceinline__ int perm32(int rho) { const int n = rho >> 4, i = rho & 15; return 8 * (i >> 2) + 4 * n + (i & 3); }

struct Unit { int pm, pn, br; };
struct Gemm { const bf16_t* A; const bf16_t* Bt; int lda, K; size_t a_br, b_br; };

struct StaticOrder {
    int nM, nN, nwg, G, c, pairs;
    __device__ void init(int M_, int N_, int G_, int c_, int pairs_) { nM = M_ / BM; nN = N_ / BM; nwg = nM * nN; G = G_; c = c_; pairs = pairs_; }
    __device__ __forceinline__ bool next(int i, Unit& u) const {
        const int ii = pairs ? (i >> 1) : i; u.br = pairs ? (i & 1) : 0;
        const long L = (long)ii * G + c; if (L >= nwg) return false;
        int wgid = (int)L; { const int q = nwg / NXCD, r = nwg % NXCD, xcd = wgid % NXCD, off = wgid / NXCD; wgid = (xcd < r ? xcd * (q + 1) : r * (q + 1) + (xcd - r) * q) + off; }
        const int nig = WGM * nN, gid = wgid / nig, fm = gid * WGM, gsz = (nM - fm) < WGM ? (nM - fm) : WGM;
        u.pm = fm + ((wgid % nig) % gsz); u.pn = (wgid % nig) / gsz; return true;
    }
};

__device__ __forceinline__ unsigned cvt_pk_bf16(float lo, float hi) { f32x2 v = {lo, hi}; bf16x2_t b = __builtin_convertvector(v, bf16x2_t); return __builtin_bit_cast(unsigned, b); }
__device__ __forceinline__ float bf_lo(unsigned w) { return __builtin_bit_cast(float, w << 16); }
__device__ __forceinline__ float bf_hi(unsigned w) { return __builtin_bit_cast(float, w & 0xffff0000u); }
__device__ __forceinline__ float sigmoidf_(float x) { return __builtin_amdgcn_rcpf(1.0f + __builtin_amdgcn_exp2f(-x * LOG2E)); }

enum { EPI_PROJ = 0, EPI_BRANCH = 1, EPI_F32 = 2, EPI_RELU2 = 3, EPI_BF16 = 4 };
template <int KIND> struct Epi {
    bf16_t* proj; void* out; int ldo;
    __device__ __forceinline__ void operator()(const f32x4 (&acc)[2][2][4][2], const Unit& u, int wr, int wc, int fr, int fq) const {
        const int row0 = u.pm * BM + wr * 64 + fr, cw = wc * 32 + 8 * fq;
        if constexpr (KIND == EPI_PROJ) {
            const int pn = u.pn;
            if (pn >= 4 && pn < 12) {
                const int col = PC_U + 128 * (pn - 4) + cw;
#pragma unroll
                for (int ai = 0; ai < 2; ++ai)
#pragma unroll
                    for (int m = 0; m < 4; ++m) { bf16_t* rp = proj + (size_t)(row0 + ai * HALF + m * 16) * LD + col;
                        const f32x4 v0 = acc[ai][0][m][0] * acc[ai][1][m][0], v1 = acc[ai][0][m][1] * acc[ai][1][m][1];
                        u32x4 w; w.x = cvt_pk_bf16(v0[0], v0[1]); w.y = cvt_pk_bf16(v0[2], v0[3]); w.z = cvt_pk_bf16(v1[0], v1[1]); w.w = cvt_pk_bf16(v1[2], v1[3]);
                        *(u32x4*)rp = w; }
            } else {
                const int colt = pn < 4 ? 256 * pn : 256 * pn - 1024; const float sc = (pn >= 12 && pn < 16) ? QSCALE : 1.0f;
                const int col = colt + cw;
#pragma unroll
                for (int ai = 0; ai < 2; ++ai)
#pragma unroll
                    for (int m = 0; m < 4; ++m) { bf16_t* rp = proj + (size_t)(row0 + ai * HALF + m * 16) * LD + col;
#pragma unroll
                        for (int bj = 0; bj < 2; ++bj) { const f32x4 v0 = acc[ai][bj][m][0] * sc, v1 = acc[ai][bj][m][1] * sc;
                            u32x4 w; w.x = cvt_pk_bf16(v0[0], v0[1]); w.y = cvt_pk_bf16(v0[2], v0[3]); w.z = cvt_pk_bf16(v1[0], v1[1]); w.w = cvt_pk_bf16(v1[2], v1[3]);
                            *(u32x4*)(rp + bj * HALF) = w; } }
            }
        } else if constexpr (KIND == EPI_BRANCH) {
            const int br = u.br, col = 256 * u.pn + cw;
            bf16_t* U = (bf16_t*)out;
#pragma unroll
            for (int ai = 0; ai < 2; ++ai)
#pragma unroll
                for (int m = 0; m < 4; ++m) { const size_t row = (size_t)(row0 + ai * HALF + m * 16); bf16_t* rp = proj + row * LD;
#pragma unroll
                    for (int bj = 0; bj < 2; ++bj) {
                        const u32x4 g = *(const u32x4*)(rp + PC_G + br * 1024 + col + bj * HALF);
                        f32x4 v0 = acc[ai][bj][m][0], v1 = acc[ai][bj][m][1];
                        v0[0] *= sigmoidf_(bf_lo(g.x)); v0[1] *= sigmoidf_(bf_hi(g.x)); v0[2] *= sigmoidf_(bf_lo(g.y)); v0[3] *= sigmoidf_(bf_hi(g.y));
                        v1[0] *= sigmoidf_(bf_lo(g.z)); v1[1] *= sigmoidf_(bf_hi(g.z)); v1[2] *= sigmoidf_(bf_lo(g.w)); v1[3] *= sigmoidf_(bf_hi(g.w));
                        if (br) { const u32x4 t = *(const u32x4*)(rp + PC_U + col + bj * HALF);
                            v0[0] += bf_lo(t.x); v0[1] += bf_hi(t.x); v0[2] += bf_lo(t.y); v0[3] += bf_hi(t.y); v1[0] += bf_lo(t.z); v1[1] += bf_hi(t.z); v1[2] += bf_lo(t.w); v1[3] += bf_hi(t.w); }
                        u32x4 w; w.x = cvt_pk_bf16(v0[0], v0[1]); w.y = cvt_pk_bf16(v0[2], v0[3]); w.z = cvt_pk_bf16(v1[0], v1[1]); w.w = cvt_pk_bf16(v1[2], v1[3]);
                        if (br) *(u32x4*)(U + row * D + col + bj * HALF) = w; else *(u32x4*)(rp + PC_U + col + bj * HALF) = w; }
                    asm volatile("" ::: "memory"); }
        } else if constexpr (KIND == EPI_F32) {
            float* O = (float*)out; const int col = 256 * u.pn + cw;
#pragma unroll
            for (int ai = 0; ai < 2; ++ai)
#pragma unroll
                for (int m = 0; m < 4; ++m) { float* rp = O + (size_t)(row0 + ai * HALF + m * 16) * ldo + col;
#pragma unroll
                    for (int bj = 0; bj < 2; ++bj) { *(f32x4*)(rp + bj * HALF) = acc[ai][bj][m][0]; *(f32x4*)(rp + bj * HALF + 4) = acc[ai][bj][m][1]; } }
        } else {
            bf16_t* O = (bf16_t*)out; const int col = 256 * u.pn + cw;
#pragma unroll
            for (int ai = 0; ai < 2; ++ai)
#pragma unroll
                for (int m = 0; m < 4; ++m) { bf16_t* rp = O + (size_t)(row0 + ai * HALF + m * 16) * ldo + col;
#pragma unroll
                    for (int bj = 0; bj < 2; ++bj) { f32x4 v0 = acc[ai][bj][m][0], v1 = acc[ai][bj][m][1];
                        if constexpr (KIND == EPI_RELU2) {
#pragma unroll
                            for (int e = 0; e < 4; ++e) { const float a = fmaxf(v0[e], 0.f), b = fmaxf(v1[e], 0.f); v0[e] = a * a; v1[e] = b * b; } }
                        u32x4 w; w.x = cvt_pk_bf16(v0[0], v0[1]); w.y = cvt_pk_bf16(v0[2], v0[3]); w.z = cvt_pk_bf16(v1[0], v1[1]); w.w = cvt_pk_bf16(v1[2], v1[3]);
                        *(u32x4*)(rp + bj * HALF) = w; } }
        }
    }
};

template <class EpiT>
__device__ __forceinline__ void gemm_phase(LAS unsigned char* lds, const Gemm g, const StaticOrder& S, const EpiT& E, const int tid) {
    const int wid = __builtin_amdgcn_readfirstlane(tid >> 6), lane = tid & 63, wr = wid >> 2, wc = wid & 3, fr = lane & 15, fq = lane >> 4;
    const int K = g.K, lda = g.lda, nt = K / BK;
    unsigned voffA[2], voffB[2];
#pragma unroll
    for (int i = 0; i < 2; ++i) { int R, C; stage_rc(tid * 16 + i * 8192, R, C); const int Rb = (R & ~31) + perm32(R & 31);
        voffA[i] = (unsigned)(R * lda + C) * 2u; voffB[i] = (unsigned)(Rb * K + C) * 2u; }
    const size_t kstep = (size_t)(BK * 2);
    const size_t hstepA = (size_t)HALF * lda * 2, hstepB = (size_t)HALF * K * 2;
    const size_t tstepA = 2 * hstepA, tstepB = 2 * hstepB;
    const unsigned ldsw = (unsigned)wid * 1024u;
    const int aoff = lds_byte(wr * 64 + fr, fq * 8), boff = lds_byte(wc * 32 + fr, fq * 8);
#define PG8_SA(b, h) (((b) * 2 + (h)) * HTB)
#define PG8_SB(b, h) ((4 + (b) * 2 + (h)) * HTB)
#define PG8_STAGE(bufoff, gbase, voff) do { _Pragma("unroll") for (int _i = 0; _i < 2; ++_i) \
        __builtin_amdgcn_global_load_lds((const unsigned*)((const char*)(gbase) + (voff)[_i]), (LAS unsigned*)(lds + (bufoff) + ldsw + _i * 8192), 16, 0, 0); } while (0)
#define PG8_LDA(dst, b, h) do { _Pragma("unroll") for (int m = 0; m < 4; ++m) _Pragma("unroll") for (int k = 0; k < 2; ++k) dst[m][k] = *(const LAS bf16x8*)(lds + PG8_SA(b, h) + aoff + m * 2048 + k * 1024); } while (0)
#define PG8_LDB(dst, b, h) do { _Pragma("unroll") for (int n = 0; n < 2; ++n) _Pragma("unroll") for (int k = 0; k < 2; ++k) dst[n][k] = *(const LAS bf16x8*)(lds + PG8_SB(b, h) + boff + n * 2048 + k * 1024); } while (0)
#define PG8_MMA(ai, bj, At, Bt) do { __builtin_amdgcn_s_setprio(1); _Pragma("unroll") for (int m = 0; m < 4; ++m) _Pragma("unroll") for (int n = 0; n < 2; ++n) _Pragma("unroll") for (int k = 0; k < 2; ++k) \
        acc[ai][bj][m][n] = __builtin_amdgcn_mfma_f32_16x16x32_bf16(Bt[n][k], At[m][k], acc[ai][bj][m][n], 0, 0, 0); __builtin_amdgcn_s_setprio(0); } while (0)
#define PG8_WAIT_V(n) asm volatile("s_waitcnt vmcnt(" #n ")" ::: "memory")
#define PG8_WAIT_L(n) asm volatile("s_waitcnt lgkmcnt(" #n ")" ::: "memory")
#define PG8_BAR __builtin_amdgcn_s_barrier()
#define PG8_SCHED __builtin_amdgcn_sched_barrier(0)
#define PG8_PTRS(u, pa, pb) do { pa = (const char*)g.A + (size_t)(u).pm * tstepA + (size_t)(u).br * g.a_br; pb = (const char*)g.Bt + (size_t)(u).pn * tstepB + (size_t)(u).br * g.b_br; } while (0)
    Unit cur, nxt; int ui = 0;
    if (!S.next(0, cur)) return;
    f32x4 acc[2][2][4][2];
#pragma unroll
    for (int a = 0; a < 2; ++a)
#pragma unroll
        for (int b = 0; b < 2; ++b)
#pragma unroll
            for (int m = 0; m < 4; ++m)
#pragma unroll
                for (int n = 0; n < 2; ++n) acc[a][b][m][n] = (f32x4){0.f, 0.f, 0.f, 0.f};
    bf16x8 At[4][2], B0[2][2], B1[2][2];
    const char* cA; const char* cB; PG8_PTRS(cur, cA, cB);
    PG8_STAGE(PG8_SB(0, 0), cB, voffB); PG8_STAGE(PG8_SB(0, 1), cB + hstepB, voffB); PG8_STAGE(PG8_SA(0, 0), cA, voffA); PG8_STAGE(PG8_SA(0, 1), cA + hstepA, voffA);
    if (wr == 1) PG8_BAR;
    PG8_WAIT_V(2); PG8_BAR;
    PG8_STAGE(PG8_SB(1, 0), cB + kstep, voffB); PG8_STAGE(PG8_SA(1, 0), cA + kstep, voffA); PG8_STAGE(PG8_SB(1, 1), cB + hstepB + kstep, voffB);
    PG8_WAIT_V(6); PG8_BAR;
    for (;;) {
        const bool has_next = S.next(ui + 1, nxt);
        const char* nA = cA; const char* nB = cB; if (has_next) PG8_PTRS(nxt, nA, nB);
        for (int t = 0; t < nt; t += 2) {
            const bool last = (t == nt - 2);
            const char* a1 = cA + (size_t)(t + 1) * kstep;
            const char* a2 = last ? nA : cA + (size_t)(t + 2) * kstep; const char* b2 = last ? nB : cB + (size_t)(t + 2) * kstep;
            const char* a3 = a2 + kstep; const char* b3 = b2 + kstep;
            PG8_LDB(B0, 0, 0); PG8_LDB(B1, 0, 1); PG8_SCHED; PG8_LDA(At, 0, 0); PG8_STAGE(PG8_SA(1, 1), a1 + hstepA, voffA);
            PG8_WAIT_V(8); PG8_WAIT_L(0); PG8_BAR; PG8_MMA(0, 0, At, B0); PG8_MMA(0, 1, At, B1); PG8_BAR; PG8_SCHED;
            PG8_LDA(At, 0, 1); PG8_STAGE(PG8_SB(0, 0), b2, voffB); PG8_STAGE(PG8_SB(0, 1), b2 + hstepB, voffB); PG8_STAGE(PG8_SA(0, 0), a2, voffA);
            PG8_WAIT_V(8); PG8_WAIT_L(0); PG8_BAR; PG8_MMA(1, 0, At, B0); PG8_MMA(1, 1, At, B1); PG8_BAR; PG8_SCHED;
            PG8_LDB(B0, 1, 0); PG8_LDB(B1, 1, 1); PG8_SCHED; PG8_LDA(At, 1, 0); PG8_STAGE(PG8_SA(0, 1), a2 + hstepA, voffA);
            PG8_WAIT_V(8); PG8_WAIT_L(0); PG8_BAR; PG8_MMA(0, 0, At, B0); PG8_MMA(0, 1, At, B1); PG8_BAR; PG8_SCHED;
            PG8_LDA(At, 1, 1); PG8_STAGE(PG8_SB(1, 0), b3, voffB); PG8_STAGE(PG8_SB(1, 1), b3 + hstepB, voffB); PG8_STAGE(PG8_SA(1, 0), a3, voffA);
            PG8_WAIT_V(8); PG8_WAIT_L(0); PG8_BAR; PG8_MMA(1, 0, At, B0); PG8_MMA(1, 1, At, B1); PG8_BAR; PG8_SCHED;
        }
        if (wr == 0) PG8_BAR;
        E(acc, cur, wr, wc, fr, fq);
        if (!has_next) break;
#pragma unroll
        for (int a = 0; a < 2; ++a)
#pragma unroll
            for (int b = 0; b < 2; ++b)
#pragma unroll
                for (int m = 0; m < 4; ++m)
#pragma unroll
                    for (int n = 0; n < 2; ++n) acc[a][b][m][n] = (f32x4){0.f, 0.f, 0.f, 0.f};
        cur = nxt; cA = nA; cB = nB; ++ui;
        if (wr == 1) PG8_BAR;
    }
    PG8_WAIT_V(0);
    PG8_BAR;
#undef PG8_SA
#undef PG8_SB
#undef PG8_STAGE
#undef PG8_LDA
#undef PG8_LDB
#undef PG8_MMA
#undef PG8_WAIT_V
#undef PG8_WAIT_L
#undef PG8_BAR
#undef PG8_SCHED
#undef PG8_PTRS
}
}

constexpr int NWAVES = 8, NTHR = NWAVES * 64;
constexpr int RING_BYTES = 131072, LDSCTL_OFF = RING_BYTES, MISC_OFF = LDSCTL_OFF + 320, LDS_BYTES = 147456;
constexpr int NPHASE = 18;
constexpr int CW_BAR = 4096;

#define RLX_AGENT __ATOMIC_RELAXED, __HIP_MEMORY_SCOPE_AGENT
#define LDS_WAIT() asm volatile("s_waitcnt lgkmcnt(0)" ::: "memory")
__device__ __forceinline__ unsigned f2bf(float f) { unsigned u = __builtin_bit_cast(unsigned, f); return (u + 0x7fffu + ((u >> 16) & 1u)) >> 16; }
__device__ __forceinline__ unsigned pk2(float lo, float hi) { return f2bf(lo) | (f2bf(hi) << 16); }
using pg8::bf_lo; using pg8::bf_hi; using pg8::cvt_pk_bf16;

#define XB_TMO      128
#define XB_XCNT(j)  (256  + 64 * (j))
#define XB_XSUB(j)  (1280 + 64 * (j))
#define XB_XGEN(j)  (2304 + 64 * (j))
#define XB_TOP      3328
#define XB_TOPGEN   3392
#define XCD_BAR_WORDS 3456
#define XB_SPIN_CAP (1u << 18)
__device__ __forceinline__ unsigned xb_ld(unsigned* p)              { return __hip_atomic_load(p, __ATOMIC_RELAXED, __HIP_MEMORY_SCOPE_AGENT); }
__device__ __forceinline__ unsigned xb_add(unsigned* p, unsigned v) { return __hip_atomic_fetch_add(p, v, __ATOMIC_RELAXED, __HIP_MEMORY_SCOPE_AGENT); }
__device__ __forceinline__ unsigned xb_xcc_id() { return (unsigned)__builtin_amdgcn_s_getreg((3 << 11) | 20) & 0xFu; }
#define XB_SPIN(cond, bar) do { unsigned _sp = 0; while (cond) { __builtin_amdgcn_s_sleep(1); \
    if ((++_sp & 255u) == 0u) { if (xb_ld(&(bar)[XB_TMO])) break; if (_sp > XB_SPIN_CAP) { atomicAdd(&(bar)[XB_TMO], 1u); break; } } } } while (0)
struct XcdBarrier { unsigned* bar; unsigned x; volatile LAS unsigned* st; };
__device__ __forceinline__ XcdBarrier xcd_barrier_post(unsigned* bar, volatile LAS unsigned* st) {
    XcdBarrier b; b.bar = bar; b.x = xb_xcc_id(); b.st = st;
    if (threadIdx.x == 0) (void)xb_add(&bar[XB_XCNT(b.x)], 1u);
    return b;
}
__device__ __forceinline__ void xcd_barrier_complete(unsigned* bar, unsigned x, unsigned& nloc, unsigned& nx) {
    const unsigned G = gridDim.x * gridDim.y * gridDim.z;
    unsigned sum, cnt, mine, sp = 0u;
    for (;;) {
        sum = 0u; cnt = 0u; mine = 0u;
#pragma unroll 1
        for (unsigned j = 0; j < 16; ++j) { const unsigned c = xb_ld(&bar[XB_XCNT(j)]); sum += c; cnt += (c > 0u) ? 1u : 0u; mine = (j == x) ? c : mine; }
        if (sum == G) break;
        __builtin_amdgcn_s_sleep(1);
        if ((++sp & 255u) == 0u) { if (xb_ld(&bar[XB_TMO])) break; if (sp > XB_SPIN_CAP) { atomicAdd(&bar[XB_TMO], 1u); break; } }
    }
    nloc = mine > 0u ? mine : 1u; nx = cnt > 0u ? cnt : 1u;
}
__device__ __forceinline__ void xcd_barrier(const XcdBarrier& b) {
    asm volatile("s_waitcnt vmcnt(0)" ::: "memory");
    __syncthreads();
    if (threadIdx.x == 0) {
        unsigned* bar = b.bar;
        __builtin_amdgcn_s_waitcnt(0);
        unsigned nloc = b.st[0], nx = b.st[1];
        if (nloc == 0u) { xcd_barrier_complete(bar, b.x, nloc, nx); b.st[0] = nloc; b.st[1] = nx; }
        const unsigned old = xb_add(&bar[XB_XSUB(b.x)], 1u);
        const unsigned gen = old / nloc;
        if (old + 1u == (gen + 1u) * nloc) {
            __builtin_amdgcn_fence(__ATOMIC_RELEASE, "agent");
            asm volatile("s_waitcnt vmcnt(0)" ::: "memory");
            const unsigned og = xb_add(&bar[XB_TOP], 1u);
            const unsigned tg = og / nx;
            if (og + 1u == (tg + 1u) * nx) xb_add(&bar[XB_TOPGEN], 1u);
            else XB_SPIN(xb_ld(&bar[XB_TOPGEN]) == tg, bar);
            __builtin_amdgcn_fence(__ATOMIC_ACQUIRE, "agent");
            xb_add(&bar[XB_XGEN(b.x)], 1u);
            asm volatile("s_waitcnt vmcnt(0)" ::: "memory");
        } else {
            XB_SPIN(xb_ld(&bar[XB_XGEN(b.x)]) == gen, bar);
            __builtin_amdgcn_fence(__ATOMIC_ACQUIRE, "agent");
            asm volatile("s_waitcnt vmcnt(0)" ::: "memory");
        }
    }
    __syncthreads();
}

struct Args { const float* in[22]; float* out; unsigned char* ws; int ph_lo, ph_hi; };
typedef const __attribute__((address_space(4))) Args* ArgsP;
__device__ __forceinline__ ArgsP args_ptr() { ArgsP p = (ArgsP)__builtin_amdgcn_kernarg_segment_ptr(); asm volatile("" : "+s"(p)); return p; }

__device__ __forceinline__ float wave_sum(float v) {
#pragma unroll
    for (int o = 1; o < 64; o <<= 1) v += __shfl_xor(v, o);
    return v;
}

__device__ __forceinline__ int win_dst_row(int c) {
    if (c >= 1024 && c < 3072) { const int x = c >= 2048, ch = c - 1024 - 1024 * x; return 1024 + 256 * (ch >> 7) + 128 * x + (ch & 127); }
    return c;
}
__device__ __forceinline__ void transpose_item(const float* W, int K, int N, bf16_t* WT, int row_off, bool perm_in, LAS float* scr, int item, int lane) {
    const int nblk = N / 32, kb = item / nblk, nb = item % nblk, k0 = 64 * kb, n0 = 32 * nb;
#pragma unroll 8
    for (int i = 0; i < 32; ++i) { const int kk = 2 * i + (lane >> 5); scr[kk * 33 + (lane & 31)] = W[(size_t)(k0 + kk) * N + n0 + (lane & 31)]; }
    LDS_WAIT(); asm volatile("" ::: "memory");
    const int c = lane & 7;
    const int r0 = row_off + (perm_in ? win_dst_row(n0) : n0);
#pragma unroll
    for (int j = 0; j < 4; ++j) { const int n = (lane >> 3) + 8 * j; const LAS float* s = scr + (8 * c) * 33 + n;
        u32x4 o; o.x = pk2(s[0 * 33], s[1 * 33]); o.y = pk2(s[2 * 33], s[3 * 33]); o.z = pk2(s[4 * 33], s[5 * 33]); o.w = pk2(s[6 * 33], s[7 * 33]);
        *(u32x4*)(WT + (size_t)(r0 + n) * K + k0 + 8 * c) = o; }
    LDS_WAIT(); asm volatile("" ::: "memory");
}
__device__ __forceinline__ void convert_weights(ArgsP a, int l, int which, LAS unsigned char* lds, int gw, int NGW, int wave, int lane) {
    LAS float* scr = (LAS float*)(lds + wave * 16384);
    bf16_t* WB = (bf16_t*)(a->ws + WS_W);
    constexpr int IT_IN = (D / 64) * (PIN / 32), IT_SQ = (D / 64) * (D / 32), IT_1 = (D / 64) * (FF / 32), IT_2 = (FF / 64) * (D / 32);
    const int n_in = (which & 1) ? IT_IN : 0, n_c = (which & 2) ? IT_SQ : 0, n_a = n_c, n_o = (which & 4) ? IT_SQ : 0, n_1 = (which & 8) ? IT_1 : 0, n_2 = (which & 16) ? IT_2 : 0;
    const int total = n_in + n_c + n_a + n_o + n_1 + n_2;
#pragma unroll 1
    for (int it = gw; it < total; it += NGW) {
        int r = it;
        if (r < n_in) { transpose_item(a->in[I_WIN] + (size_t)l * D * PIN, D, PIN, WB + WE_IN, 0, true, scr, r, lane); continue; } r -= n_in;
        if (r < n_c) { transpose_item(a->in[I_WBC] + (size_t)l * D * D, D, D, WB + WE_CA, 0, false, scr, r, lane); continue; } r -= n_c;
        if (r < n_a) { transpose_item(a->in[I_WBA] + (size_t)l * D * D, D, D, WB + WE_CA, 1024, false, scr, r, lane); continue; } r -= n_a;
        if (r < n_o) { transpose_item(a->in[I_WO] + (size_t)l * D * D, D, D, WB + WE_O, 0, false, scr, r, lane); continue; } r -= n_o;
        if (r < n_1) { transpose_item(a->in[I_WFF1] + (size_t)l * D * FF, D, FF, WB + WE_1, 0, false, scr, r, lane); continue; } r -= n_1;
        transpose_item(a->in[I_WFF2] + (size_t)l * FF * D, FF, D, WB + WE_2, 0, false, scr, r, lane);
    }
}

__device__ __forceinline__ void mod_item(ArgsP a, int item, LAS unsigned char* lds, int tid) {
    const int l = item / 128, col0 = (item % 128) * 48;
    const int lane = tid & 63, wave = __builtin_amdgcn_readfirstlane(tid >> 6);
    const float* W = a->in[I_WADA] + (size_t)l * D * (NMOD * D) + col0;
    __syncthreads();
    {
        f32x4 w[24];
#pragma unroll
        for (int p = 0; p < 24; ++p) { const int idx = p * NTHR + tid, k = idx / 12, c4 = idx - k * 12; w[p] = *(const f32x4*)(W + (size_t)k * (NMOD * D) + c4 * 4); }
#pragma unroll
        for (int p = 0; p < 24; ++p) { const int idx = p * NTHR + tid, k = idx / 12, c4 = idx - k * 12;
            u32x2 o; o.x = cvt_pk_bf16(w[p][0], w[p][1]); o.y = cvt_pk_bf16(w[p][2], w[p][3]); *(LAS u32x2*)(lds + k * 96 + c4 * 8) = o; }
    }
    __syncthreads();
    const float* cp = a->in[I_CP]; const float* cs = a->in[I_CS];
    const int fr = lane & 15, fq = lane >> 4;
    const LAS unsigned char* bbase = lds + (8 * fq + ((lane & 15) >> 2)) * 96 + (lane & 3) * 8;
    const int nmt = wave == 0 ? 2 : 1;
    float* mod = (float*)(a->ws + WS_MOD) + (size_t)l * NMROW * (NMOD * D) + col0;
    const float* bb = a->in[I_BADA] + l * NMOD * D + col0;
#pragma unroll 1
    for (int mi = 0; mi < nmt; ++mi) {
        const int mt = mi == 0 ? wave : 8;
        int row = 16 * mt + fr; row = row < NMROW ? row : NMROW - 1;
        const float* crow_ = row < NB ? cp + (size_t)row * D : cs + (size_t)(row - NB) * D;
        f32x4 acc[3];
#pragma unroll
        for (int n = 0; n < 3; ++n) acc[n] = (f32x4){0.f, 0.f, 0.f, 0.f};
#pragma unroll 4
        for (int ks = 0; ks < 32; ++ks) {
            const f32x4 c0 = *(const f32x4*)(crow_ + 32 * ks + 8 * fq), c1 = *(const f32x4*)(crow_ + 32 * ks + 8 * fq + 4);
            float sv[8] = {c0[0], c0[1], c0[2], c0[3], c1[0], c1[1], c1[2], c1[3]};
#pragma unroll
            for (int e = 0; e < 8; ++e) sv[e] = sv[e] * __builtin_amdgcn_rcpf(1.0f + __builtin_amdgcn_exp2f(-sv[e] * LOG2E));
            u32x4 aw; aw.x = cvt_pk_bf16(sv[0], sv[1]); aw.y = cvt_pk_bf16(sv[2], sv[3]); aw.z = cvt_pk_bf16(sv[4], sv[5]); aw.w = cvt_pk_bf16(sv[6], sv[7]);
            const bf16x8 af = __builtin_bit_cast(bf16x8, aw);
#pragma unroll
            for (int n = 0; n < 3; ++n) {
                const LAS unsigned char* bp = bbase + (32 * ks) * 96 + n * 32;
                const s16x4 b0 = __builtin_bit_cast(s16x4, __builtin_amdgcn_ds_read_tr16_b64_v4i16((LAS s16x4*)bp)), b1 = __builtin_bit_cast(s16x4, __builtin_amdgcn_ds_read_tr16_b64_v4i16((LAS s16x4*)(bp + 4 * 96)));
                const bf16x8 bf = {b0[0], b0[1], b0[2], b0[3], b1[0], b1[1], b1[2], b1[3]};
                acc[n] = __builtin_amdgcn_mfma_f32_16x16x32_bf16(af, bf, acc[n], 0, 0, 0);
            }
        }
#pragma unroll
        for (int n = 0; n < 3; ++n) { const float bv = bb[16 * n + fr];
#pragma unroll
            for (int r = 0; r < 4; ++r) { const int orow = 16 * mt + 4 * fq + r; if (orow < NMROW) mod[(size_t)orow * (NMOD * D) + 16 * n + fr] = acc[n][r] + bv; } }
    }
    __syncthreads();
}

__device__ __forceinline__ int t5_bucket(int n) {
    if (n < 16) return n;
    const float v = logf((float)n / 16.0f) / 2.0794415416798357f * 16.0f;
    int b = 16 + (int)v; return b < 31 ? b : 31;
}

__device__ __forceinline__ int mod_row(int m) { return m < MP ? (m >> 12) : NB + ((m - MP) >> 3); }
__device__ __forceinline__ void modnorm_store(const f32x4 (&v)[4], float ss, const float* g, const float* sh, const float* sc, bf16_t* hrow, int lane) {
    const float rstd = 1.0f / sqrtf(ss * (1.0f / D) + RMS_EPS);
#pragma unroll
    for (int j = 0; j < 4; ++j) { const int c = 4 * lane + 256 * j;
        const f32x4 gg = *(const f32x4*)(g + c), s1 = *(const f32x4*)(sc + c), s0 = *(const f32x4*)(sh + c);
        const f32x4 y = (v[j] * rstd * gg) * (s1 + 1.0f) + s0;
        u32x2 o; o.x = cvt_pk_bf16(y[0], y[1]); o.y = cvt_pk_bf16(y[2], y[3]); *(u32x2*)(hrow + c) = o; }
}
__device__ __forceinline__ float sumsq4(const f32x4 (&v)[4]) { float s = 0.f;
#pragma unroll
    for (int j = 0; j < 4; ++j) s += (v[j][0] * v[j][0] + v[j][1] * v[j][1]) + (v[j][2] * v[j][2] + v[j][3] * v[j][3]);
    return wave_sum(s); }

namespace att {
constexpr int LDS_K = 0, LDS_V = 32768, LDS_BIAS = 65536;
__device__ __forceinline__ int crow(int r, int hi) { return (r & 3) + 8 * (r >> 2) + 4 * hi; }
__device__ __forceinline__ s16x4 vtr(const LAS unsigned char* p) { return __builtin_bit_cast(s16x4, __builtin_amdgcn_ds_read_tr16_b64_v4i16((LAS s16x4*)p)); }
__device__ __forceinline__ u32x4 pack8(const float* p) { const f32x4 a = *(const f32x4*)p, b = *(const f32x4*)(p + 4); u32x4 w; w.x = pk2(a[0], a[1]); w.y = pk2(a[2], a[3]); w.z = pk2(b[0], b[1]); w.w = pk2(b[2], b[3]); return w; }

__device__ __forceinline__ void unit(LAS unsigned char* lds, bf16_t* proj, const float* biasT, const float* sinks_l, int kh, bool is_sample, int qrow0, int krow0, bool first_blk,
                                     const float* ck, const float* cv, int tid, int wave, int lane) {
    __syncthreads();
    if (!is_sample) {
        const int kbeg = first_blk ? 128 : 0;
#pragma unroll 1
        for (int idx = kbeg * 8 + tid; idx < 256 * 8; idx += NTHR) { const int kap = idx >> 3, ch = idx & 7;
            const bf16_t* src = proj + (size_t)(krow0 + kap) * LD + PC_K + kh * 64 + ch * 8;
            const u32x4 kv = *(const u32x4*)src, vv = *(const u32x4*)(src + (PC_V - PC_K));
            *(LAS u32x4*)(lds + LDS_K + kap * 128 + ((ch ^ (kap & 7)) << 4)) = kv;
            *(LAS u32x4*)(lds + LDS_V + kap * 128 + (ch << 4)) = vv; }
    } else {
#pragma unroll 1
        for (int idx = tid; idx < 128 * 8; idx += NTHR) { const int kap = idx >> 3, ch = idx & 7;
            const u32x4 kv = pack8(ck + kap * 128 + kh * 64 + ch * 8), vv = pack8(cv + kap * 128 + kh * 64 + ch * 8);
            *(LAS u32x4*)(lds + LDS_K + kap * 128 + ((ch ^ (kap & 7)) << 4)) = kv;
            *(LAS u32x4*)(lds + LDS_V + kap * 128 + (ch << 4)) = vv; }
        if (tid < 256) { const int kap = 128 + (tid >> 3), ch = tid & 7;
            const bf16_t* src = proj + (size_t)(qrow0 + ((tid >> 3) & 7)) * LD + PC_K + kh * 64 + ch * 8;
            u32x4 kv = *(const u32x4*)src, vv = *(const u32x4*)(src + (PC_V - PC_K));
            const bool z = kap >= 136; const u32x4 zero = {0u, 0u, 0u, 0u}; kv = z ? zero : kv; vv = z ? zero : vv;
            *(LAS u32x4*)(lds + LDS_K + kap * 128 + ((ch ^ (kap & 7)) << 4)) = kv;
            *(LAS u32x4*)(lds + LDS_V + kap * 128 + (ch << 4)) = vv; }
    }
    LAS float* biasL = (LAS float*)(lds + LDS_BIAS);
#pragma unroll 1
    for (int idx = tid; idx < 8 * 128; idx += NTHR) biasL[idx] = biasT[kh * 8 * 128 + idx];
    __syncthreads();
    const int h = kh * 8 + wave, r32 = lane & 31, hi = lane >> 5;
    const float sinkL = sinks_l[h] * LOG2E;
    const LAS unsigned char* vbase = lds + LDS_V + (4 * hi + ((lane & 15) >> 2)) * 128 + (16 * ((lane >> 4) & 1) + 4 * (lane & 3)) * 2;
    const LAS float* bw = biasL + wave * 128;
    const int nqt = is_sample ? 1 : 4;
#pragma unroll 1
    for (int i = 0; i < nqt; ++i) {
        const int qr = is_sample ? qrow0 + (r32 & 7) : qrow0 + 32 * i + r32;
        bf16_t* qp = proj + (size_t)qr * LD + PC_Q + h * 64;
        bf16x8 qf[4];
#pragma unroll
        for (int ks = 0; ks < 4; ++ks) qf[ks] = *(const bf16x8*)(qp + 16 * ks + 8 * hi);
        f32x16 p[5];
#pragma unroll
        for (int j = 0; j < 5; ++j) {
            const int jt = i + j; const bool skip = first_blk && jt < 4;
            f32x16 acc;
#pragma unroll
            for (int r = 0; r < 16; ++r) acc[r] = 0.f;
            if (!skip) {
#pragma unroll
                for (int ks = 0; ks < 4; ++ks) { const bf16x8 kf = *(const LAS bf16x8*)(lds + LDS_K + (32 * jt + r32) * 128 + (((2 * ks + hi) ^ (r32 & 7)) << 4));
                    acc = __builtin_amdgcn_mfma_f32_32x32x16_bf16(kf, qf[ks], acc, 0, 0, 0); }
#pragma unroll
                for (int r = 0; r < 16; ++r) { const int dd = 128 - 32 * j + r32 - crow(r, hi); const bool valid = (unsigned)dd < 128u;
                    const float b = bw[dd & 127]; acc[r] = valid ? acc[r] + b : NEG; }
            } else {
#pragma unroll
                for (int r = 0; r < 16; ++r) acc[r] = NEG;
            }
            p[j] = acc;
        }
        float mx = sinkL;
#pragma unroll
        for (int j = 0; j < 5; ++j)
#pragma unroll
            for (int r = 0; r < 16; ++r) mx = fmaxf(mx, p[j][r]);
        mx = fmaxf(mx, __shfl_xor(mx, 32));
        float sum = 0.f;
#pragma unroll
        for (int j = 0; j < 5; ++j)
#pragma unroll
            for (int r = 0; r < 16; ++r) { const float e = __builtin_amdgcn_exp2f(p[j][r] - mx); p[j][r] = e; sum += e; }
        sum += __shfl_xor(sum, 32);
        const float inv = 1.0f / (sum + __builtin_amdgcn_exp2f(sinkL - mx));
        f32x16 o0, o1;
#pragma unroll
        for (int r = 0; r < 16; ++r) { o0[r] = 0.f; o1[r] = 0.f; }
#pragma unroll
        for (int j = 0; j < 5; ++j) {
            const int jt = i + j; const bool skip = first_blk && jt < 4;
            if (!skip) {
#pragma unroll
                for (int s = 0; s < 2; ++s) {
                    u32x4 pw; pw.x = cvt_pk_bf16(p[j][8 * s + 0], p[j][8 * s + 1]); pw.y = cvt_pk_bf16(p[j][8 * s + 2], p[j][8 * s + 3]);
                    pw.z = cvt_pk_bf16(p[j][8 * s + 4], p[j][8 * s + 5]); pw.w = cvt_pk_bf16(p[j][8 * s + 6], p[j][8 * s + 7]);
                    const bf16x8 pf = __builtin_bit_cast(bf16x8, pw);
                    const LAS unsigned char* vp = vbase + (32 * jt + 16 * s) * 128;
                    const s16x4 a0 = vtr(vp), a1 = vtr(vp + 8 * 128), b0 = vtr(vp + 64), b1 = vtr(vp + 8 * 128 + 64);
                    const bf16x8 vf0 = {a0[0], a0[1], a0[2], a0[3], a1[0], a1[1], a1[2], a1[3]}, vf1 = {b0[0], b0[1], b0[2], b0[3], b1[0], b1[1], b1[2], b1[3]};
                    o0 = __builtin_amdgcn_mfma_f32_32x32x16_bf16(vf0, pf, o0, 0, 0, 0);
                    o1 = __builtin_amdgcn_mfma_f32_32x32x16_bf16(vf1, pf, o1, 0, 0, 0);
                }
            }
        }
        if (!is_sample || r32 < 8) {
#pragma unroll
            for (int g4 = 0; g4 < 4; ++g4) {
                u32x2 w0, w1;
                w0.x = cvt_pk_bf16(o0[4 * g4] * inv, o0[4 * g4 + 1] * inv); w0.y = cvt_pk_bf16(o0[4 * g4 + 2] * inv, o0[4 * g4 + 3] * inv);
                w1.x = cvt_pk_bf16(o1[4 * g4] * inv, o1[4 * g4 + 1] * inv); w1.y = cvt_pk_bf16(o1[4 * g4 + 2] * inv, o1[4 * g4 + 3] * inv);
                *(u32x2*)(qp + 8 * g4 + 4 * hi) = w0; *(u32x2*)(qp + 32 + 8 * g4 + 4 * hi) = w1;
            }
        }
    }
}
}

#define WSP(T, off) ((T*)(a->ws + (off)))
__global__ void __launch_bounds__(NTHR, 2) trunk_fwd(Args kargs) {
    extern __shared__ __attribute__((aligned(16))) unsigned char lds_raw[];
    LAS unsigned char* lds = (LAS unsigned char*)lds_raw;
    volatile LAS unsigned* MISC = (volatile LAS unsigned*)(lds + MISC_OFF);
    const int G = gridDim.x, bx = blockIdx.x;
    const int vcu = (G % 8 == 0) ? (bx % 8) * (G / 8) + bx / 8 : bx;
    for (int u = threadIdx.x; u < (LDS_BYTES - LDSCTL_OFF) / 4; u += NTHR) ((LAS unsigned*)(lds + LDSCTL_OFF))[u] = 0u;
    __syncthreads();
    XcdBarrier bar; bar.bar = nullptr; bar.x = 0; bar.st = MISC + 8;
    if (!MK_PER_PHASE_LAUNCH) { ArgsP a = args_ptr(); bar = xcd_barrier_post((unsigned*)(a->ws + WS_CTL) + CW_BAR, MISC + 8); }
    const int ph_lo = kargs.ph_lo, ph_hi = kargs.ph_hi;

    for (int ph = ph_lo; ph < ph_hi; ++ph) {
        ArgsP a = args_ptr();
        int tid = threadIdx.x; asm volatile("" : "+v"(tid));
        const int lane = tid & 63, wave = __builtin_amdgcn_readfirstlane(tid >> 6);
        const int gw = vcu * NWAVES + wave, NGW = G * NWAVES;
        if (ph == 0 && (PHMASK & 1)) {
            for (int it = bx; it < 256; it += G) mod_item(a, it, lds, tid);
            if (bx == G - 1) { float* BIAS = WSP(float, WS_BIAS); const float* rel = a->in[I_REL];
                for (int idx = tid; idx < NH * 128; idx += NTHR) { const int hh = idx >> 7, dd = idx & 127; BIAS[idx] = rel[t5_bucket(dd) * NH + hh] * LOG2E; } }
            __syncthreads();
            convert_weights(a, 0, 31, lds, gw, NGW, wave, lane);
        } else if (ph == 1 && (PHMASK & 2)) {
            const float* xp = a->in[I_XP]; const float* xs = a->in[I_XS]; const float* MOD = WSP(float, WS_MOD); bf16_t* H = WSP(bf16_t, WS_H); const float* g1 = a->in[I_GPRE1];
#pragma unroll 1
            for (int m = gw; m < M; m += NGW) {
                const float* xr = m < MP ? xp + (size_t)m * D : xs + (size_t)(m - MP) * D;
                f32x4 v[4];
#pragma unroll
                for (int j = 0; j < 4; ++j) v[j] = *(const f32x4*)(xr + 4 * lane + 256 * j);
                const float* mr = MOD + (size_t)mod_row(m) * (NMOD * D);
                modnorm_store(v, sumsq4(v), g1, mr, mr + D, H + (size_t)m * D, lane);
            }
        } else if (ph >= 2) {
            const int l = (ph - 2) >> 3, sp = (ph - 2) & 7;
            if (sp == 0 && (PHMASK & 4)) {
                pg8::Gemm g{WSP(bf16_t, WS_H), WSP(bf16_t, WS_W) + WE_IN, D, D, 0, 0}; pg8::StaticOrder S; S.init(M, PIN, G, bx, 0);
                pg8::Epi<pg8::EPI_PROJ> E{WSP(bf16_t, WS_PROJ), nullptr, 0};
                pg8::gemm_phase(lds, g, S, E, tid);
            } else if (sp == 1 && (PHMASK & 8)) {
                bf16_t* PROJ = WSP(bf16_t, WS_PROJ);
                {
                    const float* sinks_l = a->in[I_SINKS] + l * NH; const float* BIAS = WSP(float, WS_BIAS);
                    const float* ck = a->in[I_CK] + (size_t)l * NS * 128 * 128; const float* cv = a->in[I_CV] + (size_t)l * NS * 128 * 128;
                    for (int u = bx; u < 512; u += G) {
                        if (u < 256) { const int kh = u & 1, blk = u >> 1, b = blk >> 5, qb = blk & 31; const int qrow0 = b * SEQ + qb * 128;
                            att::unit(lds, PROJ, BIAS, sinks_l, kh, false, qrow0, qrow0 - 128, qb == 0, nullptr, nullptr, tid, wave, lane);
                        } else { const int v = u - 256, kh = v & 1, n = v >> 1;
                            att::unit(lds, PROJ, BIAS, sinks_l, kh, true, MP + n * TS, 0, false, ck + (size_t)n * 128 * 128, cv + (size_t)n * 128 * 128, tid, wave, lane); }
                    }
                }
                __syncthreads();
                const int gt = vcu * NTHR + tid, NGT = G * NTHR;
                {
                    const float* cw = a->in[I_CONVW] + (size_t)l * 3 * D; const float* scv = a->in[I_SCONV] + (size_t)l * NS * 2 * D; float* outp = a->out;
#pragma unroll 1
                    for (int it = gt; it < M * 128; it += NGT) {
                        const int m = it >> 7, c8 = (it & 127) * 8;
                        const bool smp = m >= MP; const int t = smp ? ((m - MP) & 7) : (m & (SEQ - 1)); const int n = smp ? ((m - MP) >> 3) : 0;
                        bf16_t* rp = PROJ + (size_t)m * LD;
                        const u32x4 bg = *(const u32x4*)(rp + PC_BG + c8), u2 = *(const u32x4*)(rp + PC_U + c8);
                        const u32x4 u1 = *(const u32x4*)(rp - (t >= 1 ? LD : 0) + PC_U + c8), u0 = *(const u32x4*)(rp - (t >= 2 ? 2 * LD : 0) + PC_U + c8);
                        const float* s1 = scv + ((size_t)n * 2 + 1) * D + c8; const float* s0 = scv + ((size_t)n * 2 + (t & 1)) * D + c8;
                        const f32x4 p1a = *(const f32x4*)s1, p1b = *(const f32x4*)(s1 + 4), p0a = *(const f32x4*)s0, p0b = *(const f32x4*)(s0 + 4);
                        const float x2[8] = {bf_lo(u2.x), bf_hi(u2.x), bf_lo(u2.y), bf_hi(u2.y), bf_lo(u2.z), bf_hi(u2.z), bf_lo(u2.w), bf_hi(u2.w)};
                        const float q1[8] = {bf_lo(u1.x), bf_hi(u1.x), bf_lo(u1.y), bf_hi(u1.y), bf_lo(u1.z), bf_hi(u1.z), bf_lo(u1.w), bf_hi(u1.w)};
                        const float q0[8] = {bf_lo(u0.x), bf_hi(u0.x), bf_lo(u0.y), bf_hi(u0.y), bf_lo(u0.z), bf_hi(u0.z), bf_lo(u0.w), bf_hi(u0.w)};
                        const float r1[8] = {p1a[0], p1a[1], p1a[2], p1a[3], p1b[0], p1b[1], p1b[2], p1b[3]}, r0[8] = {p0a[0], p0a[1], p0a[2], p0a[3], p0b[0], p0b[1], p0b[2], p0b[3]};
                        const float bgf[8] = {bf_lo(bg.x), bf_hi(bg.x), bf_lo(bg.y), bf_hi(bg.y), bf_lo(bg.z), bf_hi(bg.z), bf_lo(bg.w), bf_hi(bg.w)};
                        const f32x4 wa0 = *(const f32x4*)(cw + c8), wb0 = *(const f32x4*)(cw + c8 + 4), wa1 = *(const f32x4*)(cw + D + c8), wb1 = *(const f32x4*)(cw + D + c8 + 4), wa2 = *(const f32x4*)(cw + 2 * D + c8), wb2 = *(const f32x4*)(cw + 2 * D + c8 + 4);
                        const float w0[8] = {wa0[0], wa0[1], wa0[2], wa0[3], wb0[0], wb0[1], wb0[2], wb0[3]}, w1[8] = {wa1[0], wa1[1], wa1[2], wa1[3], wb1[0], wb1[1], wb1[2], wb1[3]}, w2[8] = {wa2[0], wa2[1], wa2[2], wa2[3], wb2[0], wb2[1], wb2[2], wb2[3]};
                        float y[8];
#pragma unroll
                        for (int e = 0; e < 8; ++e) { const float x1 = t >= 1 ? q1[e] : (smp ? r1[e] : 0.f), x0 = t >= 2 ? q0[e] : (smp ? r0[e] : 0.f);
                            y[e] = bgf[e] * (w0[e] * x0 + w1[e] * x1 + w2[e] * x2[e]); }
                        u32x4 o; o.x = cvt_pk_bf16(y[0], y[1]); o.y = cvt_pk_bf16(y[2], y[3]); o.z = cvt_pk_bf16(y[4], y[5]); o.w = cvt_pk_bf16(y[6], y[7]);
                        *(u32x4*)(rp + PC_BG + c8) = o;
                        const int tl = smp ? t - (TS - 2) : t - (SEQ - 2);
                        if (tl >= 0) { float* op = outp + (smp ? O_CONVS + (((size_t)l * NS + n) * 2 + tl) * D : O_CONVP + (((size_t)l * NB + (m >> 12)) * 2 + tl) * D) + c8;
                            *(f32x4*)op = (f32x4){x2[0], x2[1], x2[2], x2[3]}; *(f32x4*)(op + 4) = (f32x4){x2[4], x2[5], x2[6], x2[7]}; }
                    }
                }
                {
                    float* outp = a->out;
#pragma unroll 1
                    for (int it = gt; it < NB * 128 * 32; it += NGT) {
                        const int c8 = (it & 31) * 8, rr = it >> 5, b = rr >> 7, p = rr & 127;
                        const u32x4 w = *(const u32x4*)(PROJ + (size_t)(b * SEQ + SEQ - 128 + p) * LD + PC_K + c8);
                        float* op = outp + (c8 < 128 ? O_KP : O_VP) + (((size_t)l * NB + b) * 128 + p) * 128 + (c8 & 127);
                        *(f32x4*)op = (f32x4){bf_lo(w.x), bf_hi(w.x), bf_lo(w.y), bf_hi(w.y)}; *(f32x4*)(op + 4) = (f32x4){bf_lo(w.z), bf_hi(w.z), bf_lo(w.w), bf_hi(w.w)};
                    }
                    const float* ck = a->in[I_CK] + (size_t)l * NS * 128 * 128; const float* cv = a->in[I_CV] + (size_t)l * NS * 128 * 128;
#pragma unroll 1
                    for (int it = gt; it < NS * 120 * 32; it += NGT) {
                        const int c8 = (it & 31) * 8, rr = it >> 5, n = rr / 120, p = rr - n * 120; const bool isv = c8 >= 128; const int c = c8 & 127;
                        float* op = outp + (isv ? O_VS : O_KS) + (((size_t)l * NS + n) * 128 + p) * 128 + c;
                        const float* sp_ = (isv ? cv : ck) + ((size_t)n * 128 + p + 8) * 128 + c; *(f32x4*)op = *(const f32x4*)sp_; *(f32x4*)(op + 4) = *(const f32x4*)(sp_ + 4);
                    }
#pragma unroll 1
                    for (int it = gt; it < NS * 8 * 32; it += NGT) {
                        const int c8 = (it & 31) * 8, rr = it >> 5, n = rr >> 3, p = rr & 7; const bool isv = c8 >= 128; const int c = c8 & 127;
                        float* op = outp + (isv ? O_VS : O_KS) + (((size_t)l * NS + n) * 128 + 120 + p) * 128 + c;
                        const u32x4 w = *(const u32x4*)(PROJ + (size_t)(MP + n * TS + p) * LD + PC_K + c8);
                        *(f32x4*)op = (f32x4){bf_lo(w.x), bf_hi(w.x), bf_lo(w.y), bf_hi(w.y)}; *(f32x4*)(op + 4) = (f32x4){bf_lo(w.z), bf_hi(w.z), bf_lo(w.w), bf_hi(w.w)};
                    }
                }
                if (l == 0) { __syncthreads(); convert_weights(a, 1, 1, lds, gw, NGW, wave, lane); }
            } else if (sp == 2 && (PHMASK & 16)) {
                pg8::Gemm g{WSP(bf16_t, WS_PROJ) + PC_BG, WSP(bf16_t, WS_W) + WE_CA, LD, D, (size_t)(PC_Q - PC_BG) * 2, (size_t)D * D * 2}; pg8::StaticOrder S; S.init(M, D, G, bx, 1);
                pg8::Epi<pg8::EPI_BRANCH> E{WSP(bf16_t, WS_PROJ), WSP(bf16_t, WS_H), D};
                pg8::gemm_phase(lds, g, S, E, tid);
            } else if (sp == 3 && (PHMASK & 32)) {
                pg8::Gemm g{WSP(bf16_t, WS_H), WSP(bf16_t, WS_W) + WE_O, D, D, 0, 0}; pg8::StaticOrder S; S.init(M, D, G, bx, 0);
                pg8::Epi<pg8::EPI_F32> E{nullptr, WSP(float, WS_PROJ), D};
                pg8::gemm_phase(lds, g, S, E, tid);
            } else if (sp == 4 && (PHMASK & 64)) {
                const float* gp = a->in[I_GPOST1] + l * D; const float* g2 = a->in[I_GPRE2] + l * D; float* XO = a->out; const float* MIXED = WSP(float, WS_PROJ); bf16_t* H = WSP(bf16_t, WS_H);
                const float* MODL = WSP(float, WS_MOD) + (size_t)l * NMROW * (NMOD * D);
                const float* xp = l == 0 ? a->in[I_XP] : XO; const float* xs = l == 0 ? a->in[I_XS] : XO + (size_t)MP * D;
    #pragma unroll 1
            for (int m = gw; m < M; m += NGW) {
                    const float* xr = m < MP ? xp + (size_t)m * D : xs + (size_t)(m - MP) * D;
                    const float* yr = MIXED + (size_t)m * D; const float* mr = MODL + (size_t)mod_row(m) * (NMOD * D);
                    f32x4 v[4], y[4];
#pragma unroll
                    for (int j = 0; j < 4; ++j) { v[j] = *(const f32x4*)(xr + 4 * lane + 256 * j); y[j] = *(const f32x4*)(yr + 4 * lane + 256 * j); }
                    const float rstd = 1.0f / sqrtf(sumsq4(y) * (1.0f / D) + RMS_EPS);
#pragma unroll
                    for (int j = 0; j < 4; ++j) { const int c = 4 * lane + 256 * j; const f32x4 ga = *(const f32x4*)(mr + 2 * D + c), gg = *(const f32x4*)(gp + c);
                        v[j] = v[j] + ga * (y[j] * rstd * gg); *(f32x4*)(XO + (size_t)m * D + c) = v[j]; }
                    modnorm_store(v, sumsq4(v), g2, mr + 3 * D, mr + 4 * D, H + (size_t)m * D, lane);
                }
                if (l == 0) { __syncthreads(); convert_weights(a, 1, 2 | 4, lds, gw, NGW, wave, lane); }
            } else if (sp == 5 && (PHMASK & 128)) {
                pg8::Gemm g{WSP(bf16_t, WS_H), WSP(bf16_t, WS_W) + WE_1, D, D, 0, 0}; pg8::StaticOrder S; S.init(M, FF, G, bx, 0);
                pg8::Epi<pg8::EPI_RELU2> E{nullptr, WSP(bf16_t, WS_PROJ), FF};
                pg8::gemm_phase(lds, g, S, E, tid);
            } else if (sp == 6 && (PHMASK & 256)) {
                pg8::Gemm g{WSP(bf16_t, WS_PROJ), WSP(bf16_t, WS_W) + WE_2, FF, FF, 0, 0}; pg8::StaticOrder S; S.init(M, D, G, bx, 0);
                pg8::Epi<pg8::EPI_BF16> E{nullptr, WSP(bf16_t, WS_PROJ + PROJ_FFO), D};
                pg8::gemm_phase(lds, g, S, E, tid);
            } else if (sp == 7 && (PHMASK & 512)) {
                const float* gp = a->in[I_GPOST2] + l * D; float* XO = a->out; const bf16_t* FFO = WSP(bf16_t, WS_PROJ + PROJ_FFO); bf16_t* H = WSP(bf16_t, WS_H);
                const float* MODL = WSP(float, WS_MOD) + (size_t)l * NMROW * (NMOD * D);
                const float* MODN = WSP(float, WS_MOD) + (size_t)1 * NMROW * (NMOD * D); const float* g1n = a->in[I_GPRE1] + D;
    #pragma unroll 1
            for (int m = gw; m < M; m += NGW) {
                    float* xr = XO + (size_t)m * D; const bf16_t* yr = FFO + (size_t)m * D; const float* mr = MODL + (size_t)mod_row(m) * (NMOD * D);
                    f32x4 v[4], y[4];
#pragma unroll
                    for (int j = 0; j < 4; ++j) { v[j] = *(const f32x4*)(xr + 4 * lane + 256 * j); const u32x2 w = *(const u32x2*)(yr + 4 * lane + 256 * j); y[j] = (f32x4){bf_lo(w.x), bf_hi(w.x), bf_lo(w.y), bf_hi(w.y)}; }
                    const float rstd = 1.0f / sqrtf(sumsq4(y) * (1.0f / D) + RMS_EPS);
#pragma unroll
                    for (int j = 0; j < 4; ++j) { const int c = 4 * lane + 256 * j; const f32x4 ga = *(const f32x4*)(mr + 5 * D + c), gg = *(const f32x4*)(gp + c);
                        v[j] = v[j] + ga * (y[j] * rstd * gg); *(f32x4*)(xr + c) = v[j]; }
                    if (l == 0) { const float* mn = MODN + (size_t)mod_row(m) * (NMOD * D); modnorm_store(v, sumsq4(v), g1n, mn, mn + D, H + (size_t)m * D, lane); }
                }
                if (l == 0) { __syncthreads(); convert_weights(a, 1, 8 | 16, lds, gw, NGW, wave, lane); }
            }
        }
        if (ph + 1 < ph_hi) xcd_barrier(bar);
    }
}

extern "C" void kernel_launch(void* const* d_in, const int* in_sizes, int n_in, void* d_out, int out_size, void* d_ws, size_t ws_size, hipStream_t stream) {
    static int grid = 0;
    if (grid == 0) {
        if (n_in != 22 || (size_t)out_size != O_END || ws_size < WS_END) { fprintf(stderr, "kernel_launch: unexpected shapes (n_in %d out %d ws %zu); nothing launched\n", n_in, out_size, ws_size); grid = -1; return; }
        int dev = 0, cus = 0, per_cu = 0;
        if (hipGetDevice(&dev) != hipSuccess || hipDeviceGetAttribute(&cus, hipDeviceAttributeMultiprocessorCount, dev) != hipSuccess) { grid = -1; return; }
        if (hipFuncSetAttribute((const void*)trunk_fwd, hipFuncAttributeMaxDynamicSharedMemorySize, LDS_BYTES) != hipSuccess) { fprintf(stderr, "kernel_launch: hipFuncSetAttribute failed\n"); grid = -1; return; }
        if (hipOccupancyMaxActiveBlocksPerMultiprocessor(&per_cu, (const void*)trunk_fwd, NTHR, LDS_BYTES) != hipSuccess || per_cu < 1) { fprintf(stderr, "kernel_launch: occupancy query says %d\n", per_cu); per_cu = 1; }
        (void)hipGetLastError();
        grid = cus;
    }
    if (grid < 0) return;
    if (hipMemsetAsync((char*)d_ws + WS_CTL, 0, CTL_ZERO_BYTES, stream) != hipSuccess) return;
    Args a{};
    for (int i = 0; i < 22; ++i) a.in[i] = (const float*)d_in[i];
    a.out = (float*)d_out; a.ws = (unsigned char*)d_ws;
#if MK_PER_PHASE_LAUNCH
    for (int ph = 0; ph < NPHASE; ++ph) { a.ph_lo = ph; a.ph_hi = ph + 1; hipLaunchKernelGGL(trunk_fwd, dim3(grid), dim3(NTHR), LDS_BYTES, stream, a); }
#else
    a.ph_lo = 0; a.ph_hi = NPHASE;
    hipLaunchKernelGGL(trunk_fwd, dim3(grid), dim3(NTHR), LDS_BYTES, stream, a);
#endif
}
```
